# Optimizing an MI355X kernel written in HIP

```python
import jax, jax.numpy as jnp
from jax import lax
import numpy as np

D_MODEL = 1024
BATCH = 8
SEQ = 8192
DEPTH = 1

N_MEM = 256
BLOCK = 128
EPS = 1e-6
NEG = -1e30
ROPE_THETA = 500000.0

DIL_GROUPS = ((128, 1), (512, 4), (2048, 16))
N_DIL_GROUPS = 3
A_HEADS = 4
A_HEAD_DIM = 128
A_WIDTH = A_HEADS * A_HEAD_DIM
A_QKV = N_DIL_GROUPS * A_WIDTH
ROT_DIM = A_HEAD_DIM // 4

B_HEADS = 8
B_HEAD_DIM = 64
B_WIDTH = B_HEADS * B_HEAD_DIM

M_HEADS = 4
M_HEAD_DIM = 128
M_WIDTH = M_HEADS * M_HEAD_DIM

N_BRANCH = 3
IN_SIZES = (A_QKV, A_QKV, A_QKV, A_WIDTH,
            B_WIDTH, B_WIDTH, B_WIDTH, B_HEADS, B_WIDTH,
            M_WIDTH, M_WIDTH,
            N_BRANCH * D_MODEL)
IN_COLS = 3 * A_QKV + A_WIDTH + 4 * B_WIDTH + B_HEADS + 2 * M_WIDTH + N_BRANCH * D_MODEL

kernel_name = "hybrid_dilated_fox_memory_gated_block"


def rmsnorm(x, g):
    x32 = x.astype(jnp.float32)
    y = x32 * lax.rsqrt(jnp.mean(x32 * x32, axis=-1, keepdims=True) + EPS)
    return (y * g.astype(jnp.float32)).astype(x.dtype)


def rope_partial(x, pos):
    half = ROT_DIM // 2
    inv = ROPE_THETA ** (-jnp.arange(half, dtype=jnp.float32) / half)
    ang = pos.astype(jnp.float32)[..., None] * inv
    cos = jnp.cos(ang)[:, :, None, :]
    sin = jnp.sin(ang)[:, :, None, :]
    xr = x[..., :ROT_DIM].astype(jnp.float32)
    x1, x2 = xr[..., :half], xr[..., half:]
    rot = jnp.concatenate([x1 * cos - x2 * sin, x2 * cos + x1 * sin], axis=-1).astype(x.dtype)
    return jnp.concatenate([rot, x[..., ROT_DIM:]], axis=-1)


def dilated_window_attention(q, k, v, window, dilation):
    bsz, seq, nh, hd = q.shape
    L = seq // dilation
    steps = window // dilation
    Lp = -(-L // BLOCK) * BLOCK
    nb = Lp // BLOCK

    def to_classes(t):
        t = t.reshape(bsz, L, dilation, nh, hd).transpose(0, 2, 3, 1, 4)
        return jnp.pad(t, ((0, 0), (0, 0), (0, 0), (0, Lp - L), (0, 0)))

    def band(t):
        t = jnp.pad(t, ((0, 0), (0, 0), (0, 0), (BLOCK, 0), (0, 0)))
        t = t.reshape(bsz, dilation, nh, nb + 1, BLOCK, hd)
        return jnp.concatenate([t[:, :, :, :-1], t[:, :, :, 1:]], axis=4)

    qb = to_classes(q).reshape(bsz, dilation, nh, nb, BLOCK, hd)
    kb = band(to_classes(k))
    vb = band(to_classes(v))
    s = jnp.einsum('brhnqd,brhnkd->brhnqk', qb, kb).astype(jnp.float32) * (hd ** -0.5)
    qi = jnp.arange(BLOCK)[:, None]
    ki = jnp.arange(2 * BLOCK)[None, :]
    rel = BLOCK + qi - ki
    blk = jnp.arange(nb)[:, None, None]
    valid = (rel >= 0) & (rel <= steps) & (blk * BLOCK + ki - BLOCK >= 0)
    s = jnp.where(valid, s, NEG)
    m = jnp.max(s, axis=-1, keepdims=True)
    p = jnp.exp(s - m)
    den = jnp.sum(p, axis=-1)
    o = jnp.einsum('brhnqk,brhnkd->brhnqd', p.astype(v.dtype), vb).astype(jnp.float32) / den[..., None]
    lse = m[..., 0] + jnp.log(den)
    o = o.reshape(bsz, dilation, nh, Lp, hd)[:, :, :, :L].transpose(0, 3, 1, 2, 4).reshape(bsz, seq, nh, hd)
    lse = lse.reshape(bsz, dilation, nh, Lp)[..., :L].transpose(0, 3, 1, 2).reshape(bsz, seq, nh)
    return o, lse


def forgetting_attention(q, k, v, log_f):
    bsz, seq, nh, hd = q.shape
    nb = seq // BLOCK
    c = jnp.cumsum(log_f, axis=1).transpose(0, 2, 1)
    kt = k.transpose(0, 2, 1, 3)
    vt = v.transpose(0, 2, 1, 3)
    qb = q.transpose(0, 2, 1, 3).reshape(bsz, nh, nb, BLOCK, hd).transpose(2, 0, 1, 3, 4)
    cb = c.reshape(bsz, nh, nb, BLOCK).transpose(2, 0, 1, 3)
    kpos = jnp.arange(seq)

    def one_block(args):
        n, qn, cn = args
        s = jnp.einsum('bhqd,bhkd->bhqk', qn, kt).astype(jnp.float32) * (hd ** -0.5)
        s = s + cn[..., :, None] - c[:, :, None, :]
        qpos = n * BLOCK + jnp.arange(BLOCK)
        s = jnp.where(kpos[None, :] <= qpos[:, None], s, NEG)
        p = jax.nn.softmax(s, axis=-1)
        return jnp.einsum('bhqk,bhkd->bhqd', p.astype(vt.dtype), vt)

    o = lax.map(one_block, (jnp.arange(nb), qb, cb))
    return o.transpose(1, 0, 3, 2, 4).reshape(bsz, seq, nh, hd)


def memory_attention(q, mem_k, mem_v):
    s = jnp.einsum('bshd,bnhd->bhsn', q, mem_k).astype(jnp.float32) * (q.shape[-1] ** -0.5)
    p = jax.nn.softmax(s, axis=-1)
    return jnp.einsum('bhsn,bnhd->bshd', p.astype(mem_v.dtype), mem_v)


def setup_inputs(seed: int = 0) -> dict:
    key = jax.random.key(seed)
    ks = jax.random.split(key, 16)
    f32 = jnp.float32
    x = jax.random.normal(ks[0], (BATCH, SEQ, D_MODEL), f32)
    mem = jax.random.normal(ks[1], (BATCH, N_MEM, D_MODEL), f32)
    start = jax.random.randint(ks[2], (BATCH, 1), 0, 4096, dtype=jnp.int32)
    positions = start + jnp.arange(SEQ, dtype=jnp.int32)[None, :]
    norm_pre_g = 1.0 + 0.05 * jax.random.normal(ks[3], (DEPTH, D_MODEL), f32)
    norm_post_g = 1.0 + 0.05 * jax.random.normal(ks[4], (DEPTH, D_MODEL), f32)
    norm_mem_g = 1.0 + 0.05 * jax.random.normal(ks[5], (DEPTH, D_MODEL), f32)
    w_in = jax.random.normal(ks[6], (DEPTH, D_MODEL, IN_COLS), f32) * D_MODEL ** -0.5
    b_forget = 3.0 + 0.5 * jax.random.normal(ks[7], (DEPTH, B_HEADS), f32)
    b_merge = 0.01 * jax.random.normal(ks[8], (DEPTH, N_BRANCH * D_MODEL), f32)
    w_mem_kv = jax.random.normal(ks[9], (DEPTH, D_MODEL, 2 * M_WIDTH), f32) * D_MODEL ** -0.5
    w_branch_a = jax.random.normal(ks[10], (DEPTH, A_WIDTH, D_MODEL), f32) * A_WIDTH ** -0.5
    w_branch_b = jax.random.normal(ks[11], (DEPTH, B_WIDTH, D_MODEL), f32) * B_WIDTH ** -0.5
    w_branch_m = jax.random.normal(ks[12], (DEPTH, M_WIDTH, D_MODEL), f32) * M_WIDTH ** -0.5
    w_out = jax.random.normal(ks[13], (DEPTH, D_MODEL, D_MODEL), f32) * D_MODEL ** -0.5
    return {"x": x, "mem": mem, "positions": positions,
            "norm_pre_g": norm_pre_g, "norm_post_g": norm_post_g, "norm_mem_g": norm_mem_g,
            "w_in": w_in, "b_forget": b_forget, "b_merge": b_merge, "w_mem_kv": w_mem_kv,
            "w_branch_a": w_branch_a, "w_branch_b": w_branch_b, "w_branch_m": w_branch_m,
            "w_out": w_out}


def reference(x, mem, positions, norm_pre_g, norm_post_g, norm_mem_g, w_in, b_forget, b_merge,
              w_mem_kv, w_branch_a, w_branch_b, w_branch_m, w_out):
    bsz, seq, _ = x.shape
    split_at = [int(i) for i in np.cumsum(IN_SIZES)[:-1]]
    for layer in range(DEPTH):
        h = rmsnorm(x, norm_pre_g[layer])
        u = jnp.einsum('bsd,de->bse', h, w_in[layer])
        (qa, ka, va, za, qb, kb, vb, fb, zb, qm, zm, gl) = jnp.split(u, split_at, axis=-1)

        nh_a = N_DIL_GROUPS * A_HEADS
        qa = rope_partial(qa.reshape(bsz, seq, nh_a, A_HEAD_DIM), positions)
        ka = rope_partial(ka.reshape(bsz, seq, nh_a, A_HEAD_DIM), positions)
        va = va.reshape(bsz, seq, nh_a, A_HEAD_DIM)
        outs, lses = [], []
        for g, (window, dilation) in enumerate(DIL_GROUPS):
            sl = slice(g * A_HEADS, (g + 1) * A_HEADS)
            o_g, lse_g = dilated_window_attention(qa[:, :, sl], ka[:, :, sl], va[:, :, sl], window, dilation)
            outs.append(o_g)
            lses.append(lse_g)
        wgt = jax.nn.softmax(jnp.stack(lses, axis=0), axis=0)
        y_a = jnp.sum(wgt[..., None] * jnp.stack(outs, axis=0), axis=0)
        y_a = y_a.astype(x.dtype).reshape(bsz, seq, A_WIDTH) * jax.nn.silu(za)

        log_f = jax.nn.log_sigmoid((fb + b_forget[layer]).astype(jnp.float32))
        y_b = forgetting_attention(qb.reshape(bsz, seq, B_HEADS, B_HEAD_DIM),
                                   kb.reshape(bsz, seq, B_HEADS, B_HEAD_DIM),
                                   vb.reshape(bsz, seq, B_HEADS, B_HEAD_DIM), log_f)
        y_b = y_b.reshape(bsz, seq, B_WIDTH) * jax.nn.silu(zb)

        mkv = jnp.einsum('bnd,de->bne', rmsnorm(mem, norm_mem_g[layer]), w_mem_kv[layer])
        mk, mv = jnp.split(mkv, 2, axis=-1)
        y_m = memory_attention(qm.reshape(bsz, seq, M_HEADS, M_HEAD_DIM),
                               mk.reshape(bsz, N_MEM, M_HEADS, M_HEAD_DIM),
                               mv.reshape(bsz, N_MEM, M_HEADS, M_HEAD_DIM))
        y_m = y_m.reshape(bsz, seq, M_WIDTH) * jax.nn.silu(zm)

        gates = jax.nn.sigmoid(gl + b_merge[layer]).reshape(bsz, seq, N_BRANCH, D_MODEL)
        merged = (gates[:, :, 0] * jnp.einsum('bse,ed->bsd', y_a, w_branch_a[layer])
                  + gates[:, :, 1] * jnp.einsum('bse,ed->bsd', y_b, w_branch_b[layer])
                  + gates[:, :, 2] * jnp.einsum('bse,ed->bsd', y_m, w_branch_m[layer]))
        out = jnp.einsum('bsd,de->bse', merged, w_out[layer])
        x = x + rmsnorm(out, norm_post_g[layer])
    return x
```

```cpp
#include <hip/hip_runtime.h>
#include <hip/hip_cooperative_groups.h>
#include <hip/hip_bf16.h>
#include <cstdio>
#include <cstdint>
#include <cmath>
namespace cg = cooperative_groups;
namespace pg8 {
#define PG8_LAS __attribute__((address_space(3)))
typedef unsigned short bf16_t;
typedef short bf16x8 __attribute__((ext_vector_type(8)));
typedef float f32x4 __attribute__((ext_vector_type(4)));
typedef unsigned u32x4 __attribute__((ext_vector_type(4)));
constexpr int BM = 256, BK = 64, HALF = 128, HTB = HALF * BK * 2  , STAGE_BYTES = 8 * HTB, NXCD = 8, WGM = 4;

__host__ __device__ __forceinline__ int lds_byte(int r, int c) { const int st = (r >> 4) * 2 + (c >> 5), rr = r & 15, cc = c & 31, ob = rr * 64 + cc * 2; return st * 1024 + (ob ^ (((ob >> 9) & 1) << 5)); }
__host__ __device__ __forceinline__ void stage_rc(int b, int& R, int& C) { const int st = b / 1024, sb = b % 1024, swz = sb ^ (((sb >> 9) & 1) << 5); R = (st >> 1) * 16 + swz / 64; C = (st & 1) * 32 + (swz % 64) / 2; }
__host__ __device__ __forceinline__ int perm32(int rho) { const int n = rho >> 4, i = rho & 15; return 8 * (i >> 2) + 4 * n + (i & 3); }

struct Unit { int pm, pn; };
struct Gemm { const bf16_t* A; const bf16_t* Bt; int M, N, K, lda; };

struct StaticOrder {
    int nM, nN, nwg, G, c;
    __host__ __device__ void init(int M, int N, int G_, int c_) { nM = M / BM; nN = N / BM; nwg = nM * nN; G = G_; c = c_; }
    __host__ __device__ bool next(int i, Unit& u) const {
        const long L = (long)i * G + c; if (L >= nwg) return false;
        int wgid = (int)L; { const int q = nwg / NXCD, r = nwg % NXCD, xcd = wgid % NXCD, off = wgid / NXCD; wgid = (xcd < r ? xcd * (q + 1) : r * (q + 1) + (xcd - r) * q) + off; }
        const int nig = WGM * nN, gid = wgid / nig, fm = gid * WGM, gsz = (nM - fm) < WGM ? (nM - fm) : WGM;
        u.pm = fm + ((wgid % nig) % gsz); u.pn = (wgid % nig) / gsz; return true;
    }
    __device__ __forceinline__ void a_ready(const Unit&) const {}
    __device__ __forceinline__ void done(const Unit&) const {}
};

__device__ __forceinline__ unsigned cvt_pk_bf16(float lo, float hi) { unsigned r; asm volatile("v_cvt_pk_bf16_f32 %0, %1, %2" : "=v"(r) : "v"(lo), "v"(hi)); return r; }
typedef float f32x2 __attribute__((ext_vector_type(2)));
template <class Epi, class Sched, bool ALIGN_EPI = false, bool SP2 = false>
__device__ __forceinline__ void gemm_phase(PG8_LAS unsigned char* lds, const Gemm g, const Sched& S, const Epi& E) {
    int tid = threadIdx.x; asm volatile("" : "+v"(tid));
    const int wid = __builtin_amdgcn_readfirstlane(tid >> 6), lane = tid & 63, wr = wid >> 2, wc = wid & 3, fr = lane & 15, fq = lane >> 4;
    const int K = g.K, nt = K / BK;
    unsigned voffA[2], voffB[2];
#pragma unroll
    for (int i = 0; i < 2; ++i) { int R, C; stage_rc(tid * 16 + i * 8192, R, C); const int Rb = Epi::PERM ? ((R & ~31) + perm32(R & 31)) : R;
        voffA[i] = (unsigned)(R * g.lda + C) * 2u; voffB[i] = (unsigned)(Rb * K + C) * 2u; }
    const size_t kstep = (size_t)(BK * 2);
    const size_t hstepA = (size_t)HALF * g.lda * 2, hstepB = (size_t)HALF * K * 2;
    const size_t tstepA = 2 * hstepA, tstepB = 2 * hstepB;
    const unsigned ldsw = (unsigned)wid * 1024u;
    const int aoff = lds_byte(wr * 64 + fr, fq * 8), boff = lds_byte(wc * 32 + fr, fq * 8);
#define PG8_SA(b, h) (((b) * 2 + (h)) * HTB)
#define PG8_SB(b, h) ((4 + (b) * 2 + (h)) * HTB)
#define PG8_STAGE(bufoff, gbase, voff) do { _Pragma("unroll") for (int _i = 0; _i < 2; ++_i) \
        __builtin_amdgcn_global_load_lds((const unsigned*)((const char*)(gbase) + (voff)[_i]), (PG8_LAS unsigned*)(lds + (bufoff) + ldsw + _i * 8192), 16, 0, 0); } while (0)
#define PG8_LDA(dst, b, h) do { _Pragma("unroll") for (int m = 0; m < 4; ++m) _Pragma("unroll") for (int k = 0; k < 2; ++k) dst[m][k] = *(const PG8_LAS bf16x8*)(lds + PG8_SA(b, h) + aoff + m * 2048 + k * 1024); } while (0)
#define PG8_LDB(dst, b, h) do { _Pragma("unroll") for (int n = 0; n < 2; ++n) _Pragma("unroll") for (int k = 0; k < 2; ++k) dst[n][k] = *(const PG8_LAS bf16x8*)(lds + PG8_SB(b, h) + boff + n * 2048 + k * 1024); } while (0)
#define PG8_MMA(ai, bj, At, Bt) do { __builtin_amdgcn_s_setprio(1); _Pragma("unroll") for (int m = 0; m < 4; ++m) _Pragma("unroll") for (int n = 0; n < 2; ++n) _Pragma("unroll") for (int k = 0; k < 2; ++k) \
        acc[ai][bj][m][n] = __builtin_amdgcn_mfma_f32_16x16x32_bf16(Bt[n][k], At[m][k], acc[ai][bj][m][n], 0, 0, 0); __builtin_amdgcn_s_setprio(0); } while (0)
#define PG8_WAIT_V(n) asm volatile("s_waitcnt vmcnt(" #n ")" ::: "memory")
#define PG8_WAIT_L(n) asm volatile("s_waitcnt lgkmcnt(" #n ")" ::: "memory")
#define PG8_BAR __builtin_amdgcn_s_barrier()
#define PG8_SCHED __builtin_amdgcn_sched_barrier(0)
    Unit cur, nxt; int ui = 0;
    if (!S.next(0, cur)) return;
    f32x4 acc[2][2][4][2];
#pragma unroll
    for (int a = 0; a < 2; ++a)
#pragma unroll
        for (int b = 0; b < 2; ++b)
#pragma unroll
            for (int m = 0; m < 4; ++m)
#pragma unroll
                for (int n = 0; n < 2; ++n) acc[a][b][m][n] = (f32x4){0.f, 0.f, 0.f, 0.f};
    bf16x8 At[4][2], B0[2][2], B1[2][2];
    const char* cA = (const char*)g.A + (size_t)cur.pm * tstepA; const char* cB = (const char*)g.Bt + (size_t)cur.pn * tstepB;
    S.a_ready(cur);
    if constexpr (SP2) {
        PG8_STAGE(PG8_SB(0, 0), cB, voffB); PG8_STAGE(PG8_SB(0, 1), cB + hstepB, voffB); PG8_STAGE(PG8_SA(0, 0), cA, voffA); PG8_STAGE(PG8_SA(0, 1), cA + hstepA, voffA);
        if (wr == 1) PG8_BAR;
        PG8_WAIT_V(2); PG8_BAR;
        PG8_STAGE(PG8_SB(1, 0), cB + kstep, voffB); PG8_STAGE(PG8_SA(1, 0), cA + kstep, voffA); PG8_STAGE(PG8_SB(1, 1), cB + hstepB + kstep, voffB);
        PG8_WAIT_V(6); PG8_BAR;
    } else {
        PG8_STAGE(PG8_SB(0, 0), cB, voffB); PG8_STAGE(PG8_SA(0, 0), cA, voffA); PG8_STAGE(PG8_SB(0, 1), cB + hstepB, voffB); PG8_STAGE(PG8_SA(0, 1), cA + hstepA, voffA);
        if (wr == 1) PG8_BAR;
        PG8_WAIT_V(4); PG8_BAR;
        PG8_STAGE(PG8_SB(1, 0), cB + kstep, voffB); PG8_STAGE(PG8_SA(1, 0), cA + kstep, voffA); PG8_STAGE(PG8_SB(1, 1), cB + hstepB + kstep, voffB);
        PG8_WAIT_V(6); PG8_BAR;
    }
    for (;;) {
        const bool has_next = S.next(ui + 1, nxt);
        const char* nA = has_next ? (const char*)g.A + (size_t)nxt.pm * tstepA : cA; const char* nB = has_next ? (const char*)g.Bt + (size_t)nxt.pn * tstepB : cB;
        for (int t = 0; t < nt; t += 2) {
            const bool last = (t == nt - 2);
            const char* a1 = cA + (size_t)(t + 1) * kstep;
            const char* a2 = last ? nA : cA + (size_t)(t + 2) * kstep; const char* b2 = last ? nB : cB + (size_t)(t + 2) * kstep;
            const char* a3 = a2 + kstep; const char* b3 = b2 + kstep;
            if (last && has_next) S.a_ready(nxt);
            if constexpr (SP2) {
            PG8_LDB(B0, 0, 0); PG8_LDB(B1, 0, 1); PG8_SCHED; PG8_LDA(At, 0, 0); PG8_STAGE(PG8_SA(1, 1), a1 + hstepA, voffA);
            PG8_WAIT_V(8); PG8_WAIT_L(0); PG8_BAR; PG8_MMA(0, 0, At, B0); PG8_MMA(0, 1, At, B1); PG8_BAR; PG8_SCHED;
            PG8_LDA(At, 0, 1); PG8_STAGE(PG8_SB(0, 0), b2, voffB); PG8_STAGE(PG8_SB(0, 1), b2 + hstepB, voffB); PG8_STAGE(PG8_SA(0, 0), a2, voffA);
            PG8_WAIT_V(8); PG8_WAIT_L(0); PG8_BAR; PG8_MMA(1, 0, At, B0); PG8_MMA(1, 1, At, B1); PG8_BAR; PG8_SCHED;
            PG8_LDB(B0, 1, 0); PG8_LDB(B1, 1, 1); PG8_SCHED; PG8_LDA(At, 1, 0); PG8_STAGE(PG8_SA(0, 1), a2 + hstepA, voffA);
            PG8_WAIT_V(8); PG8_WAIT_L(0); PG8_BAR; PG8_MMA(0, 0, At, B0); PG8_MMA(0, 1, At, B1); PG8_BAR; PG8_SCHED;
            PG8_LDA(At, 1, 1); PG8_STAGE(PG8_SB(1, 0), b3, voffB); PG8_STAGE(PG8_SB(1, 1), b3 + hstepB, voffB); PG8_STAGE(PG8_SA(1, 0), a3, voffA);
            PG8_WAIT_V(8); PG8_WAIT_L(0); PG8_BAR; PG8_MMA(1, 0, At, B0); PG8_MMA(1, 1, At, B1); PG8_BAR; PG8_SCHED;
            } else {
            PG8_LDB(B0, 0, 0); PG8_SCHED; PG8_LDA(At, 0, 0); PG8_STAGE(PG8_SA(1, 1), a1 + hstepA, voffA);
            PG8_WAIT_L(8); PG8_BAR; PG8_WAIT_L(0); PG8_MMA(0, 0, At, B0); PG8_BAR; PG8_SCHED;
            PG8_LDB(B1, 0, 1); PG8_STAGE(PG8_SB(0, 0), b2, voffB);
            PG8_BAR; PG8_WAIT_L(0); PG8_MMA(0, 1, At, B1); PG8_BAR;
            PG8_LDA(At, 0, 1); PG8_STAGE(PG8_SA(0, 0), a2, voffA);
            PG8_BAR; PG8_WAIT_L(0); PG8_MMA(1, 0, At, B0); PG8_BAR; PG8_SCHED;
            PG8_STAGE(PG8_SB(0, 1), b2 + hstepB, voffB);
            PG8_WAIT_V(6); PG8_BAR; PG8_MMA(1, 1, At, B1); PG8_BAR;
            PG8_LDB(B0, 1, 0); PG8_SCHED; PG8_LDA(At, 1, 0); PG8_STAGE(PG8_SA(0, 1), a2 + hstepA, voffA);
            PG8_WAIT_L(8); PG8_BAR; PG8_WAIT_L(0); PG8_MMA(0, 0, At, B0); PG8_BAR; PG8_SCHED;
            PG8_LDB(B1, 1, 1); PG8_STAGE(PG8_SB(1, 0), b3, voffB);
            PG8_BAR; PG8_WAIT_L(0); PG8_MMA(0, 1, At, B1); PG8_BAR;
            PG8_LDA(At, 1, 1); PG8_STAGE(PG8_SA(1, 0), a3, voffA);
            PG8_BAR; PG8_WAIT_L(0); PG8_MMA(1, 0, At, B0); PG8_BAR; PG8_SCHED;
            PG8_STAGE(PG8_SB(1, 1), b3 + hstepB, voffB);
            PG8_WAIT_V(6); PG8_BAR; PG8_MMA(1, 1, At, B1); PG8_BAR;
            }
        }
        if constexpr (ALIGN_EPI) { if (wr == 0) PG8_BAR; }
        if constexpr (!Epi::AFTER_DRAIN) { E(acc, cur, wr, wc, fr, fq, lane); S.done(cur); }
        if (!has_next) break;
#pragma unroll
        for (int a = 0; a < 2; ++a)
#pragma unroll
            for (int b = 0; b < 2; ++b)
#pragma unroll
                for (int m = 0; m < 4; ++m)
#pragma unroll
                    for (int n = 0; n < 2; ++n) acc[a][b][m][n] = (f32x4){0.f, 0.f, 0.f, 0.f};
        cur = nxt; cA = nA; cB = nB; ++ui;
        if constexpr (ALIGN_EPI) { if (wr == 1) PG8_BAR; }
    }
    PG8_WAIT_V(0);
    if constexpr (!ALIGN_EPI) { if (wr == 0) PG8_BAR; }
    PG8_BAR;
    if constexpr (Epi::AFTER_DRAIN) { E.fused(acc, cur, wr, wc, fr, fq, lds, wid, lane); S.done(cur); }
#undef PG8_SA
#undef PG8_SB
#undef PG8_STAGE
#undef PG8_LDA
#undef PG8_LDB
#undef PG8_MMA
#undef PG8_WAIT_V
#undef PG8_WAIT_L
#undef PG8_BAR
#undef PG8_SCHED
}
}
#define PG8_SP2 true
#include <hip/hip_bf16.h>
#include <cmath>
namespace attn_body {
using bf16=__hip_bfloat16;
using bf16x8=__attribute__((ext_vector_type(8)))short;
using s16x4=__attribute__((ext_vector_type(4)))short;
using f32x16=__attribute__((ext_vector_type(16)))float;
using u32x4=__attribute__((ext_vector_type(4)))unsigned;
using f32x4v=__attribute__((ext_vector_type(4)))float;
constexpr int BATCH=8,NHEAD=8,SEQ=8192,D=64,DM=6656;
constexpr int NW=8,QBLK=32,QB=QBLK*NW,KVBLK=64,NQB=SEQ/QB;
constexpr int ATTN_PITCH=DM, ATTN_UNIT_ROWS=QB;
__device__ __forceinline__ int crow(int r,int hi){return (r&3)+8*(r>>2)+4*hi;}
#define SBAR() __builtin_amdgcn_sched_barrier(0)
__device__ __forceinline__ void cmask(f32x16&p0,f32x16&p1,int jb,int qrel,int hi){
  const float NEG=-INFINITY; int kb=64*jb+4*hi;
  #pragma unroll
  for(int r=0;r<16;++r){int kv=kb+(r&3)+8*(r>>2); if(kv>qrel)p0[r]=NEG; if(kv+32>qrel)p1[r]=NEG;}
}

constexpr int NSLOT=3, SLOTB=8192;
constexpr int LDS_K=0, LDS_V=NSLOT*SLOTB, LDS_WS=2*NSLOT*SLOTB, LDS_OST=LDS_WS+NW*64*4, LDS_CB=LDS_OST+NW*4096, LDS_BYTES=LDS_CB+SEQ*4;
constexpr float C2=0.125f*1.4426950408889634f;
__device__ __forceinline__ void glds16(const void*gsrc,unsigned lds_dst){unsigned keep;
  asm volatile("s_mov_b32 %0, m0\n\ts_mov_b32 m0, %2\n\ts_nop 0\n\tglobal_load_lds_dwordx4 %1, off\n\ts_mov_b32 m0, %0":"=&s"(keep):"v"(gsrc),"s"(lds_dst):"memory");}
__device__ __forceinline__ float max3f(float a,float b,float c){float r;asm("v_max3_f32 %0, %1, %2, %3":"=v"(r):"v"(a),"v"(b),"v"(c));return r;}
__device__ __forceinline__ float max2f(float a,float b){float r;asm("v_max_f32_e32 %0, %1, %2":"=v"(r):"v"(a),"v"(b));return r;}
__device__ __forceinline__ float fadd_s(float a,float b){float r;asm("v_add_f32_e32 %0, %1, %2":"=v"(r):"v"(a),"v"(b));return r;}
__device__ __forceinline__ float fsub_s(float a,float b){float r;asm("v_sub_f32_e32 %0, %1, %2":"=v"(r):"v"(a),"v"(b));return r;}
typedef float f32x2_t __attribute__((ext_vector_type(2))); typedef __bf16 bf16x2_t __attribute__((ext_vector_type(2)));
__device__ __forceinline__ unsigned cvtpk_s(float lo,float hi){f32x2_t v={lo,hi};bf16x2_t b=__builtin_convertvector(v,bf16x2_t);return __builtin_bit_cast(unsigned,b);}
#define WAIT_BAR(N) asm volatile("s_waitcnt vmcnt(" #N ") lgkmcnt(0)\n\ts_barrier":::"memory")

__device__ __forceinline__ void qkt(f32x16&p0,f32x16&p1,const char*Kslot,const bf16x8*qr,const f32x16&negm,int r32,int hi){
  const char*kb=Kslot+hi*1024+r32*16;
  #pragma unroll
  for(int d0=0;d0<4;++d0){
    const bf16x8 b0=*reinterpret_cast<const bf16x8*>(kb+d0*2048);
    const bf16x8 b1=*reinterpret_cast<const bf16x8*>(kb+d0*2048+512);
    if(d0==0){p0=__builtin_amdgcn_mfma_f32_32x32x16_bf16(b0,qr[0],negm,0,0,0);p1=__builtin_amdgcn_mfma_f32_32x32x16_bf16(b1,qr[0],negm,0,0,0);}
    else{p0=__builtin_amdgcn_mfma_f32_32x32x16_bf16(b0,qr[d0],p0,0,0,0);p1=__builtin_amdgcn_mfma_f32_32x32x16_bf16(b1,qr[d0],p1,0,0,0);}}
}
typedef __attribute__((address_space(3))) const char* lds_cptr;
typedef short v4i16_t __attribute__((ext_vector_type(4)));
__device__ __forceinline__ void kload8(bf16x8*kf,lds_cptr kp){
  kf[0]=*(const __attribute__((address_space(3))) bf16x8*)(kp);      kf[1]=*(const __attribute__((address_space(3))) bf16x8*)(kp+512);
  kf[2]=*(const __attribute__((address_space(3))) bf16x8*)(kp+2048); kf[3]=*(const __attribute__((address_space(3))) bf16x8*)(kp+2560);
  kf[4]=*(const __attribute__((address_space(3))) bf16x8*)(kp+4096); kf[5]=*(const __attribute__((address_space(3))) bf16x8*)(kp+4608);
  kf[6]=*(const __attribute__((address_space(3))) bf16x8*)(kp+6144); kf[7]=*(const __attribute__((address_space(3))) bf16x8*)(kp+6656);
}
__device__ __forceinline__ void kload2(bf16x8*kf,lds_cptr kp,int j){ kf[2*j]=*(const __attribute__((address_space(3))) bf16x8*)(kp+j*2048); kf[2*j+1]=*(const __attribute__((address_space(3))) bf16x8*)(kp+j*2048+512); }
__device__ __forceinline__ s16x4 vtr(lds_cptr p){ return __builtin_bit_cast(s16x4,__builtin_amdgcn_ds_read_tr16_b64_v4i16((__attribute__((address_space(3))) v4i16_t*)p)); }
__device__ __forceinline__ float rowmax(const f32x16&p0,const f32x16&p1){
  float a=max3f(p0[0],p0[1],p1[0]),b=max3f(p0[2],p0[3],p1[1]);a=max3f(a,p1[2],p1[3]);
  #pragma unroll
  for(int r=4;r<16;r+=4){a=max3f(a,p0[r],p0[r+1]);b=max3f(b,p0[r+2],p0[r+3]);a=max3f(a,p1[r],p1[r+1]);b=max3f(b,p1[r+2],p1[r+3]);}
  const float m=max2f(a,b);
  auto rr=__builtin_amdgcn_permlane32_swap(__float_as_uint(m),__float_as_uint(m),false,false);
  return max2f(__uint_as_float(rr[0]),__uint_as_float(rr[1]));
}
__device__ __forceinline__ void pv(f32x16*o,int vb,bf16x8 pa0,bf16x8 pa1,bf16x8 pa2,bf16x8 pa3){
  #pragma unroll
  for(int d0=0;d0<2;++d0){s16x4 lo[4],hi[4];
    #pragma unroll
    for(int ks=0;ks<4;++ks){
      asm volatile("ds_read_b64_tr_b16 %0,%1 offset:%c2":"=&v"(lo[ks]):"v"(vb),"i"(d0*4096+ks*1024):"memory");
      asm volatile("ds_read_b64_tr_b16 %0,%1 offset:%c2":"=&v"(hi[ks]):"v"(vb),"i"(d0*4096+ks*1024+512):"memory");}
    asm volatile("s_waitcnt lgkmcnt(0)":::"memory");SBAR();
    #define PK(k) (bf16x8){lo[k][0],lo[k][1],lo[k][2],lo[k][3],hi[k][0],hi[k][1],hi[k][2],hi[k][3]}
    o[d0]=__builtin_amdgcn_mfma_f32_32x32x16_bf16(pa0,PK(0),o[d0],0,0,0);
    o[d0]=__builtin_amdgcn_mfma_f32_32x32x16_bf16(pa1,PK(1),o[d0],0,0,0);
    o[d0]=__builtin_amdgcn_mfma_f32_32x32x16_bf16(pa2,PK(2),o[d0],0,0,0);
    o[d0]=__builtin_amdgcn_mfma_f32_32x32x16_bf16(pa3,PK(3),o[d0],0,0,0);
    #undef PK
  }
}

#ifndef ATTN_STORE16
#define ATTN_STORE16(p,v) (*(u32x4*)(p)=(v))
#endif
template<int THRL> __device__ __forceinline__ void attn_unit(int b,int h,int qb,const bf16*Q,const bf16*__restrict__ K,const bf16*__restrict__ V,bf16*O,const float*__restrict__ CB,const float*__restrict__ NRM,char*shm){
  const int tid=threadIdx.x,lane=tid&63,r32=lane&31,hi=lane>>5; const int wid=__builtin_amdgcn_readfirstlane(tid>>6);
  const long rowbase=(long)b*SEQ; const int q0=qb*QB;
  const bf16*Qw=Q+(rowbase+q0+wid*QBLK)*DM+h*D;
  int ts;
  { const float*cbg0=CB+(long)(b*NHEAD+h)*SEQ; const float*nq=NRM+((b*8+h)*32+qb)*2,*nk=NRM+4096+(b*8+h)*2;
    const float q0s=__uint_as_float(__hip_atomic_load((const unsigned*)nq,__ATOMIC_RELAXED,__HIP_MEMORY_SCOPE_AGENT)),q1s=__uint_as_float(__hip_atomic_load((const unsigned*)nq+1,__ATOMIC_RELAXED,__HIP_MEMORY_SCOPE_AGENT)),k0s=__uint_as_float(__hip_atomic_load((const unsigned*)nk,__ATOMIC_RELAXED,__HIP_MEMORY_SCOPE_AGENT)),k1s=__uint_as_float(__hip_atomic_load((const unsigned*)nk+1,__ATOMIC_RELAXED,__HIP_MEMORY_SCOPE_AGENT));
    const float thr=2.02f*(sqrtf(q0s*k0s)+sqrtf(q1s*k1s))+24.0f; const int ntf=(q0+QB)/KVBLK; const int tc=2*(lane+1);
    bool ok=false; if(tc<=ntf-4) ok=(cbg0[q0]-cbg0[64*tc-1])>=thr;
    ts=2*__builtin_popcountll(__ballot(ok)); ts=__builtin_amdgcn_readfirstlane(ts); }
  const bf16*Kh=K+(rowbase+(long)ts*KVBLK)*DM+h*D,*Vh=V+(rowbase+(long)ts*KVBLK)*DM+h*D;
  const unsigned lds0=(unsigned)(uintptr_t)shm;
  float*wsf=(float*)(shm+LDS_WS)+wid*64;
  const bf16*ksrc=Kh+(long)lane*DM+wid*8;
  const bf16*vsrc=Vh+(long)(16*(wid&3)+(lane>>2))*DM+(wid>>2)*32+(lane&3)*8;
  const unsigned kdst=lds0+LDS_K+wid*1024, vdst=lds0+LDS_V+wid*1024;
  #define DMA_K(t,slot) glds16(ksrc+(long)(t)*KVBLK*DM,(unsigned)__builtin_amdgcn_readfirstlane(kdst+(slot)))
  #define DMA_V(t,slot) glds16(vsrc+(long)(t)*KVBLK*DM,(unsigned)__builtin_amdgcn_readfirstlane(vdst+(slot)))
  const int vb0=(int)(lds0+LDS_V)+((lane>>4)&1)*32+(lane&3)*8+(4*hi+((lane&15)>>2))*64;
  const char*Kbase=shm+LDS_K; bf16x8 kf[8];
  const lds_cptr shm3=(lds_cptr)shm; const lds_cptr kp0=shm3+LDS_K+hi*1024+r32*16; const lds_cptr vp0=shm3+LDS_V+((lane>>4)&1)*32+(lane&3)*8+(4*hi+((lane&15)>>2))*64;
  const int NT=(q0+QB)/KVBLK-ts;
  { const float*cbg=CB+(long)(b*NHEAD+h)*SEQ+ts*KVBLK; __attribute__((address_space(3))) float*cbl=(__attribute__((address_space(3))) float*)((lds_cptr)shm+LDS_CB);
    for(int i=tid*4;i<q0+QB-ts*KVBLK;i+=2048){ const f32x4v v=*reinterpret_cast<const f32x4v*>(cbg+i); *(__attribute__((address_space(3))) f32x4v*)(cbl+i)=v; } }
  const __attribute__((address_space(3))) float*cbw=(const __attribute__((address_space(3))) float*)((lds_cptr)shm+LDS_CB)+4*hi;
  #define BIAS(P0,P1,t) do{ const __attribute__((address_space(3))) float*cp_=cbw+64*(t); _Pragma("unroll") for(int j_=0;j_<4;++j_){ const f32x4v a_=*(const __attribute__((address_space(3))) f32x4v*)(cp_+8*j_); const f32x4v b_=*(const __attribute__((address_space(3))) f32x4v*)(cp_+32+8*j_); \
      P0[4*j_]+=a_[0];P0[4*j_+1]+=a_[1];P0[4*j_+2]+=a_[2];P0[4*j_+3]+=a_[3]; P1[4*j_]+=b_[0];P1[4*j_+1]+=b_[1];P1[4*j_+2]+=b_[2];P1[4*j_+3]+=b_[3]; } }while(0)
  #define BLOAD(P0,P1,t) do{ const __attribute__((address_space(3))) float*cp_=cbw+64*(t); _Pragma("unroll") for(int j_=0;j_<4;++j_){ const f32x4v a_=*(const __attribute__((address_space(3))) f32x4v*)(cp_+8*j_); const f32x4v b_=*(const __attribute__((address_space(3))) f32x4v*)(cp_+32+8*j_); \
      P0[4*j_]=a_[0];P0[4*j_+1]=a_[1];P0[4*j_+2]=a_[2];P0[4*j_+3]=a_[3]; P1[4*j_]=b_[0];P1[4*j_+1]=b_[1];P1[4*j_+2]=b_[2];P1[4*j_+3]=b_[3]; } }while(0)
  #define BSUB(P0,P1) do{ _Pragma("unroll") for(int r_=0;r_<16;++r_){P0[r_]-=mhat;P1[r_]-=mhat;} }while(0)
  DMA_K(0,0);DMA_V(0,0);DMA_K(1,SLOTB);
  bf16x8 qr[4];
  #pragma unroll
  for(int d0=0;d0<4;++d0)qr[d0]=*reinterpret_cast<const bf16x8*>(&Qw[(long)r32*DM+d0*16+hi*8]);
  float mhat=0.f,l_reg=0.f;f32x16 o[2];o[0]=f32x16{};o[1]=f32x16{};f32x16 negm=f32x16{};asm volatile("":"+v"(negm));
  const int qrel=wid*QBLK+r32;
  #define CMASK(P0,P1,t) do{int jb_=(t)-(NT-4); if(jb_>=0)cmask(P0,P1,jb_,qrel,hi);}while(0)
  bool resc=false;
  #define START(P0,P1) do{ const float rm=rowmax(P0,P1); resc=false; \
    { const float dl=rm; mhat=fadd_s(mhat,dl); \
      _Pragma("unroll") for(int r=0;r<16;++r){P0[r]=fsub_s(P0[r],dl);P1[r]=fsub_s(P1[r],dl);} \
      } \
    _Pragma("unroll") for(int r=0;r<16;++r)P0[r]=__builtin_amdgcn_exp2f(P0[r]); }while(0)
  #define RESC() do{ if(resc){ asm volatile("s_waitcnt lgkmcnt(0)":::"memory"); \
      _Pragma("unroll") for(int d_=0;d_<2;++d_) _Pragma("unroll") for(int r=0;r<16;++r)o[d_][r]*=wsf[crow(r,hi)]; } }while(0)
  f32x16 pA0,pA1,pB0,pB1;
  int sl_prev=0,sl_cur=0,sl_next=SLOTB;
  #define ROT() do{sl_prev=sl_cur;sl_cur=sl_next;sl_next=(sl_next==(NSLOT-1)*SLOTB)?0:sl_next+SLOTB;}while(0)
  DMA_K(2,2*SLOTB);
  WAIT_BAR(3);
  qkt(pA0,pA1,Kbase,qr,negm,r32,hi);asm volatile("s_nop 15\n\ts_nop 7":"+v"(pA0),"+v"(pA1));BIAS(pA0,pA1,0);CMASK(pA0,pA1,0);
  START(pA0,pA1);
  _Pragma("unroll") for(int r=0;r<16;++r)pA1[r]=__builtin_amdgcn_exp2f(pA1[r]);
  WAIT_BAR(0);
  DMA_K(3,0);DMA_V(1,SLOTB);
  ROT();
  BLOAD(pB0,pB1,1); BSUB(pB0,pB1);
  kload8(kf,kp0+sl_cur);
  WAIT_BAR(2);
  s16x4 vlo[8],vhi[8]; u32x4 pw0,pw1,pw2,pw3;
  #define PKW(P,B) cvtpk_s(P[B],P[B+1])
  #define PAF(k) __builtin_bit_cast(bf16x8,pw##k)
  #define VFR(i) (bf16x8){vlo[i][0],vlo[i][1],vlo[i][2],vlo[i][3],vhi[i][0],vhi[i][1],vhi[i][2],vhi[i][3]}
  #define PIN(x) asm volatile("":"+v"(x))
  #define MX3(a,b,c) __builtin_fmaxf(__builtin_fmaxf((a),(b)),(c))
  #define GAPA(MF,A0,A1,A2,A3,W0,W1,PW) do{ MF; sacc+=A0; sacc+=A1; sacc+=A2; sacc+=A3; PIN(sacc); W0; W1; PIN(PW); SBAR(); }while(0)
  #define EX(v) __builtin_amdgcn_exp2f(v)
  #define GAPB(MF,X,B) do{ MF; X[B]=EX(X[B]); X[B+1]=EX(X[B+1]); X[B+2]=EX(X[B+2]); X[B+3]=EX(X[B+3]); PIN(X); SBAR(); }while(0)
  #define VRD(i) do{ vlo[i]=vtr(vp_+(((i)>>2)*4096+((i)&3)*1024)); vhi[i]=vtr(vp_+(((i)>>2)*4096+((i)&3)*1024+512)); }while(0)
  #define KRD(G,j) do{ if(G){ kload2(kf,kp0+sl_next,j); SBAR(); } }while(0)
  #define STEP(C0,C1,P0,P1,t,GK,GV,GL) do{ SBAR(); \
    const lds_cptr vp_=vp0+sl_prev; \
    VRD(0); SBAR(); float sacc=(P0[0]+P0[1]); \
    GAPA(C0=__builtin_amdgcn_mfma_f32_32x32x16_bf16(kf[0],qr[0],C0,0,0,0), P0[2],P0[3],P0[4],P0[5],     pw0[0]=PKW(P0,0), pw0[1]=PKW(P0,2), pw0); \
    VRD(4); SBAR(); GAPA(C1=__builtin_amdgcn_mfma_f32_32x32x16_bf16(kf[1],qr[0],C1,0,0,0), P0[6],P0[7],P0[8],P0[9],     pw0[2]=PKW(P0,4), pw0[3]=PKW(P0,6), pw0); \
    VRD(1); SBAR(); GAPA(C0=__builtin_amdgcn_mfma_f32_32x32x16_bf16(kf[2],qr[1],C0,0,0,0),   P0[10],P0[11],P0[12],P0[13], pw1[0]=PKW(P0,8), pw1[1]=PKW(P0,10), pw1); \
    VRD(5); SBAR(); GAPA(C1=__builtin_amdgcn_mfma_f32_32x32x16_bf16(kf[3],qr[1],C1,0,0,0),   P0[14],P0[15],P1[0],P1[1],   pw1[2]=PKW(P0,12),pw1[3]=PKW(P0,14), pw1); \
    VRD(2); SBAR(); GAPA(C0=__builtin_amdgcn_mfma_f32_32x32x16_bf16(kf[4],qr[2],C0,0,0,0),   P1[2],P1[3],P1[4],P1[5],     pw2[0]=PKW(P1,0), pw2[1]=PKW(P1,2), pw2); \
    VRD(6); SBAR(); GAPA(C1=__builtin_amdgcn_mfma_f32_32x32x16_bf16(kf[5],qr[2],C1,0,0,0),   P1[6],P1[7],P1[8],P1[9],     pw2[2]=PKW(P1,4), pw2[3]=PKW(P1,6), pw2); \
    VRD(3); SBAR(); GAPA(C0=__builtin_amdgcn_mfma_f32_32x32x16_bf16(kf[6],qr[3],C0,0,0,0),   P1[10],P1[11],P1[12],P1[13], pw3[0]=PKW(P1,8), pw3[1]=PKW(P1,10), pw3); \
    VRD(7); SBAR(); GAPA(C1=__builtin_amdgcn_mfma_f32_32x32x16_bf16(kf[7],qr[3],C1,0,0,0),   P1[14],P1[15],0.f,0.f,       pw3[2]=PKW(P1,12),pw3[3]=PKW(P1,14), pw3); \
    l_reg+=sacc; \
    if(GK){DMA_K((t)+3,sl_cur);} if(GV){DMA_V((t)+1,sl_next);} \
    CMASK(C0,C1,t); \
    { float a=MX3(C0[0],C0[1],C1[0]),b=MX3(C0[2],C0[3],C1[1]); a=MX3(a,C1[2],C1[3]); \
      _Pragma("unroll") for(int r=4;r<16;r+=4){a=MX3(a,C0[r],C0[r+1]);b=MX3(b,C0[r+2],C0[r+3]);a=MX3(a,C1[r],C1[r+1]);b=MX3(b,C1[r+2],C1[r+3]);} \
      float rm=__builtin_fmaxf(a,b); { auto rr=__builtin_amdgcn_permlane32_swap(__float_as_uint(rm),__float_as_uint(rm),false,false); rm=__builtin_fmaxf(__uint_as_float(rr[0]),__uint_as_float(rr[1])); } \
      resc=false; \
      if(__builtin_expect(__any(rm>(float)THRL),0)){ const float dl=__builtin_fmaxf(rm,0.f); mhat+=dl; \
        _Pragma("unroll") for(int r=0;r<16;++r){C0[r]-=dl;C1[r]-=dl;} \
        const float f=__builtin_amdgcn_exp2f(-dl); l_reg*=f; if(hi==0)wsf[r32]=f; resc=true; } } \
    SBAR(); BLOAD(P0,P1,(t)+1); SBAR(); \
    GAPB(o[0]=__builtin_amdgcn_mfma_f32_32x32x16_bf16(PAF(0),VFR(0),o[0],0,0,0), C0,0); \
    GAPB(o[1]=__builtin_amdgcn_mfma_f32_32x32x16_bf16(PAF(0),VFR(4),o[1],0,0,0), C0,4); \
    KRD(GL,0); GAPB(o[0]=__builtin_amdgcn_mfma_f32_32x32x16_bf16(PAF(1),VFR(1),o[0],0,0,0), C0,8); \
    KRD(GL,1); GAPB(o[1]=__builtin_amdgcn_mfma_f32_32x32x16_bf16(PAF(1),VFR(5),o[1],0,0,0), C0,12); \
    KRD(GL,2); GAPB(o[0]=__builtin_amdgcn_mfma_f32_32x32x16_bf16(PAF(2),VFR(2),o[0],0,0,0), C1,0); \
    KRD(GL,3); GAPB(o[1]=__builtin_amdgcn_mfma_f32_32x32x16_bf16(PAF(2),VFR(6),o[1],0,0,0), C1,4); \
    GAPB(o[0]=__builtin_amdgcn_mfma_f32_32x32x16_bf16(PAF(3),VFR(3),o[0],0,0,0), C1,8); \
    GAPB(o[1]=__builtin_amdgcn_mfma_f32_32x32x16_bf16(PAF(3),VFR(7),o[1],0,0,0), C1,12); \
    BSUB(P0,P1); \
    }while(0)
  int t=1;
  #undef CMASK
  #define CMASK(P0,P1,t) do{}while(0)
  for(;t+5<NT;t+=2){
    STEP(pB0,pB1,pA0,pA1,t,true,true,true);     WAIT_BAR(2); RESC(); ROT();
    STEP(pA0,pA1,pB0,pB1,t+1,true,true,true);   WAIT_BAR(2); RESC(); ROT();
  }
  #undef CMASK
  #define CMASK(P0,P1,t) do{int jb_=(t)-(NT-4); if(jb_>=0)cmask(P0,P1,jb_,qrel,hi);}while(0)
  #define ENDW(tt) do{ if((tt)+3<NT){WAIT_BAR(2);} else if((tt)+2<NT){WAIT_BAR(1);} else {WAIT_BAR(0);} }while(0)
  for(;t+1<NT;t+=2){
    STEP(pB0,pB1,pA0,pA1,t,(t+3<NT),(t+1<NT),(t+1<NT));       ENDW(t);   RESC(); ROT();
    STEP(pA0,pA1,pB0,pB1,t+1,(t+4<NT),(t+2<NT),(t+2<NT));     ENDW(t+1); RESC(); ROT();
  }
  STEP(pB0,pB1,pA0,pA1,NT-1,false,false,false); RESC();
  { float sacc=pB0[0]+pB0[1]; _Pragma("unroll") for(int r=2;r<16;++r)sacc+=pB0[r]; _Pragma("unroll") for(int r=0;r<16;++r)sacc+=pB1[r]; l_reg+=sacc;
    pw0=(u32x4){PKW(pB0,0),PKW(pB0,2),PKW(pB0,4),PKW(pB0,6)};pw1=(u32x4){PKW(pB0,8),PKW(pB0,10),PKW(pB0,12),PKW(pB0,14)};pw2=(u32x4){PKW(pB1,0),PKW(pB1,2),PKW(pB1,4),PKW(pB1,6)};pw3=(u32x4){PKW(pB1,8),PKW(pB1,10),PKW(pB1,12),PKW(pB1,14)};
    SBAR(); pv(o,vb0+sl_cur,PAF(0),PAF(1),PAF(2),PAF(3)); }
  #undef PKW
  #undef PAF
  #undef VFR
  #undef PIN
  #undef MX3
  #undef GAPA
  #undef GAPB
  #undef EX
  #undef VRD
  #undef KRD
  #undef STEP
  #undef ENDW
  {auto rr=__builtin_amdgcn_permlane32_swap(__float_as_uint(l_reg),__float_as_uint(l_reg),false,false);l_reg=__uint_as_float(rr[0])+__uint_as_float(rr[1]);}
  if(hi==0)wsf[32+r32]=l_reg;asm volatile("s_waitcnt lgkmcnt(0)":::"memory");
  float rli[16];
  #pragma unroll
  for(int r=0;r<16;++r)rli[r]=__builtin_amdgcn_rcpf(wsf[32+crow(r,hi)]);
  bf16*Ow=O+(rowbase+q0+wid*QBLK)*DM+h*D;
  { bf16*stg=(bf16*)(shm+LDS_OST)+wid*2048;
    #pragma unroll
    for(int r=0;r<16;++r){const int orow=crow(r,hi);
      #pragma unroll
      for(int d0=0;d0<2;++d0)stg[orow*64+d0*32+r32]=__float2bfloat16(o[d0][r]*rli[r]);}
    asm volatile("s_waitcnt lgkmcnt(0)":::"memory");
    #pragma unroll
    for(int i=0;i<4;++i){const int row=i*8+(lane>>3),ch=lane&7; const u32x4 v=*(const u32x4*)(stg+row*64+ch*8); ATTN_STORE16(Ow+(long)row*DM+ch*8,v);} }
  asm volatile("s_waitcnt lgkmcnt(0)\n\ts_barrier":::"memory");
  #undef DMA_K
  #undef BIAS
  #undef BLOAD
  #undef BSUB
  #undef DMA_V
  #undef CMASK
  #undef START
  #undef RESC
  #undef ROT
}
constexpr int ATTN_LDS_BYTES=LDS_BYTES;
struct AttnTensors { const bf16* Q; const bf16* K; const bf16* V; bf16* O; const float* CB; const float* NRM; };
struct AttnUnit { int bh; int qb; };
struct StaticOrder {
  int g,c;
  __device__ __forceinline__ explicit StaticOrder(int grid,int block):g(grid),c(block){}
  __device__ __forceinline__ bool next(int i,AttnUnit&u)const{
    if(g==256){ if(i>=8)return false; const int cc=c>>3; u.bh=(c&7)*8+i; u.qb=(cc+4*i)&31; return true; }
    const int e=c+i*g; if(e>=2048)return false; u.bh=e&63; u.qb=31-(e>>6); return true; }
  __device__ __forceinline__ void a_ready(const AttnUnit&)const{}
  __device__ __forceinline__ void done(const AttnUnit&)const{}
};
template<class Sched,int THRL=40> __device__ __forceinline__ void attn_phase(char*lds,const AttnTensors&T,const Sched&S){
  AttnUnit u;
  for(int i=0;S.next(i,u);++i){ S.a_ready(u); attn_unit<THRL>(u.bh/NHEAD,u.bh%NHEAD,u.qb,T.Q,T.K,T.V,T.O,T.CB,T.NRM,lds); S.done(u); }
}
#undef SBAR
#undef WAIT_BAR
}
namespace mk {
#define LAS3 __attribute__((address_space(3)))
typedef unsigned short bf16_t;
typedef short bf16x8 __attribute__((ext_vector_type(8)));
typedef float f32x4 __attribute__((ext_vector_type(4)));
typedef unsigned u32x4 __attribute__((ext_vector_type(4)));
typedef unsigned u32x2 __attribute__((ext_vector_type(2)));
constexpr int NB = 8, S = 8192, DM = 1024, NTOK = NB * S, NMEM = 256;
constexpr int IN_COLS = 11272, UP = 6656;
constexpr int C_QA = 0, C_KA = 1536, C_VA = 3072, C_QB = 4608, C_KB = 5120, C_VB = 5632, C_QM = 6144, C_OUT = 512;
constexpr float EPS = 1e-6f, LOG2E = 1.4426950408889634f;
constexpr float SC128 = 0.08838834764831845f * LOG2E;
constexpr float SC64 = 0.125f * LOG2E;
constexpr size_t MiB = 1u << 20;
constexpr size_t OFF_U = 0, OFF_H = 832 * MiB, OFF_WT = 960 * MiB, OFF_WA = 982 * MiB, OFF_WB = 983 * MiB, OFF_WM = 984 * MiB, OFF_WOUT = 985 * MiB,
                 OFF_WMEM = 987 * MiB, OFF_HM = 989 * MiB, OFF_MKV = 993 * MiB, OFF_LOGF = 997 * MiB, OFF_CB2 = 999 * MiB, OFF_LSE = 1001 * MiB, OFF_ROWSS = 1004 * MiB, OFF_WP = 1005 * MiB, WS_NEED = 1011 * MiB;
static_assert((size_t)NTOK * UP * 2 == 832 * MiB, "U size");
constexpr int LDS_BYTES = 147456;

struct Params {
    const float* x; const float* mem; const int* pos; const float* g_pre; const float* g_post; const float* g_mem; const float* w_in; const float* b_forget; const float* b_merge;
    const float* w_mem_kv; const float* w_a; const float* w_b; const float* w_m; const float* w_out; float* out; unsigned char* ws;
};

typedef float f32x2_mk __attribute__((ext_vector_type(2))); typedef __bf16 bf16x2_mk __attribute__((ext_vector_type(2)));
__device__ __forceinline__ unsigned pk_bf16(float lo, float hi) { f32x2_mk v = {lo, hi}; bf16x2_mk b = __builtin_convertvector(v, bf16x2_mk); return __builtin_bit_cast(unsigned, b); }
__device__ __forceinline__ float bf_lo(unsigned w) { return __uint_as_float(w << 16); }
__device__ __forceinline__ float bf_hi(unsigned w) { return __uint_as_float(w & 0xffff0000u); }
__device__ __forceinline__ float wave_sum(float v) {
#pragma unroll
    for (int o = 32; o >= 1; o >>= 1) v += __shfl_xor(v, o);
    return v;
}
__device__ __forceinline__ float silu_f(float v) { return v * __builtin_amdgcn_rcpf(1.0f + __builtin_amdgcn_exp2f(-v * LOG2E)); }
__device__ __forceinline__ float sigmoid_f(float v) { return __builtin_amdgcn_rcpf(1.0f + __builtin_amdgcn_exp2f(-v * LOG2E)); }
__device__ __forceinline__ void blk_sync_mem() {
    asm volatile("s_waitcnt vmcnt(0) lgkmcnt(0)" ::: "memory"); __syncthreads(); asm volatile("buffer_inv sc1" ::: "memory");
}

__device__ __forceinline__ int wt_colmap(int n0) {
    if (n0 < 4608) return n0;
    if (n0 < 6144) return n0 + 512;
    if (n0 < 6656) return n0 - 6144 + 7176;
    if (n0 < 7168) return n0 - 6656 + 4608;
    if (n0 < 7680) return n0 - 7168 + 6664;
    if (n0 < 8192) return n0 - 7680 + 7688;
    return n0 - 8192 + 8200;
}
__device__ __forceinline__ void tr_tile(LAS3 float* tile, const float* src, int lds_, int c0, int k0, bf16_t* dst, int ldd, int n0) {
    int tid = threadIdx.x; asm volatile("" : "+v"(tid));
#pragma unroll
    for (int i = 0; i < 2; ++i) { const int k = (tid >> 4) + 32 * i, n4 = (tid & 15) * 4;
        const f32x4 v = *(const f32x4*)(src + (size_t)(k0 + k) * lds_ + c0 + n4);
        tile[k * 65 + n4] = v[0]; tile[k * 65 + n4 + 1] = v[1]; tile[k * 65 + n4 + 2] = v[2]; tile[k * 65 + n4 + 3] = v[3]; }
    __syncthreads();
    { const int n = tid >> 3, kc = (tid & 7) * 8; u32x4 w;
      w.x = pk_bf16(tile[(kc + 0) * 65 + n], tile[(kc + 1) * 65 + n]); w.y = pk_bf16(tile[(kc + 2) * 65 + n], tile[(kc + 3) * 65 + n]);
      w.z = pk_bf16(tile[(kc + 4) * 65 + n], tile[(kc + 5) * 65 + n]); w.w = pk_bf16(tile[(kc + 6) * 65 + n], tile[(kc + 7) * 65 + n]);
      *(u32x4*)(dst + (size_t)(n0 + n) * ldd + k0 + kc) = w; }
    __syncthreads();
}
__device__ void phase0(const Params& p, LAS3 unsigned char* lds) {
    int tid = threadIdx.x; asm volatile("" : "+v"(tid)); const int lane = tid & 63, wid = tid >> 6, G = gridDim.x; int bid = blockIdx.x; asm volatile("" : "+s"(bid));
    size_t wz = 0; asm volatile("" : "+s"(wz)); unsigned char* ws = p.ws + wz;
    { LAS3 float* tile = (LAS3 float*)lds;
      for (int t = bid; t < 3712; t += G) {
          if (t < 2816) { const int nt = t >> 4, kt = t & 15; tr_tile(tile, p.w_in, IN_COLS, wt_colmap(nt * 64), kt * 64, (bf16_t*)(ws + OFF_WT), 1024, nt * 64); }
          else if (t < 3200) { const int q = t - 2816, w = q >> 7, r = q & 127, nt = r >> 3, kt = r & 7;
              const float* src = w == 0 ? p.w_a : (w == 1 ? p.w_b : p.w_m); tr_tile(tile, src, 1024, nt * 64, kt * 64, (bf16_t*)(ws + OFF_WA + (size_t)w * MiB), 512, nt * 64); }
          else if (t < 3456) { const int q = t - 3200, nt = q >> 4, kt = q & 15; tr_tile(tile, p.w_out, 1024, nt * 64, kt * 64, (bf16_t*)(ws + OFF_WOUT), 1024, nt * 64); }
          else { const int q = t - 3456, nt = q >> 4, kt = q & 15; tr_tile(tile, p.w_mem_kv, 1024, nt * 64, kt * 64, (bf16_t*)(ws + OFF_WMEM), 1024, nt * 64); }
      } }
    if (bid == 0) for (int i = tid; i < 4096 + 128; i += 512) ((unsigned*)(ws + OFF_ROWSS))[i] = 0u;
    __syncthreads();
    LAS3 float* wfb = (LAS3 float*)lds;
    for (int i = tid; i < 2048; i += 512) { const int k = i >> 1, hf = i & 1; const f32x4 v = *(const f32x4*)(p.w_in + (size_t)k * IN_COLS + 6656 + hf * 4); *(LAS3 f32x4*)(wfb + k * 8 + hf * 4) = v; }
    __syncthreads();
    bf16_t* H = (bf16_t*)(ws + OFF_H); float* LOGF = (float*)(ws + OFF_LOGF);
    f32x4 v[4];
    { const int r0 = bid * 8 + wid; if (r0 < NTOK) {
#pragma unroll
        for (int i = 0; i < 4; ++i) v[i] = *(const f32x4*)(p.x + (size_t)r0 * DM + 4 * lane + 256 * i); } }
    for (int row = bid * 8 + wid; row < NTOK; row += G * 8) {
        const int nrow = row + G * 8; f32x4 nv[4];
#pragma unroll
        for (int i = 0; i < 4; ++i) nv[i] = (f32x4){0.f, 0.f, 0.f, 0.f};
        if (nrow < NTOK) {
#pragma unroll
            for (int i = 0; i < 4; ++i) nv[i] = *(const f32x4*)(p.x + (size_t)nrow * DM + 4 * lane + 256 * i); }
        float ss = 0.f;
#pragma unroll
        for (int i = 0; i < 4; ++i) ss += v[i][0] * v[i][0] + v[i][1] * v[i][1] + v[i][2] * v[i][2] + v[i][3] * v[i][3];
        ss = wave_sum(ss); const float rstd = rsqrtf(ss * (1.0f / DM) + EPS);
        float fa[8];
#pragma unroll
        for (int e = 0; e < 8; ++e) fa[e] = 0.f;
#pragma unroll
        for (int i = 0; i < 4; ++i) { const int k = 4 * lane + 256 * i; const f32x4 g = *(const f32x4*)(p.g_pre + k); f32x4 y = v[i] * rstd * g;
            u32x2 w; w.x = pk_bf16(y[0], y[1]); w.y = pk_bf16(y[2], y[3]); *(u32x2*)(H + (size_t)row * DM + k) = w;
#pragma unroll
            for (int j = 0; j < 4; ++j) { const f32x4 w0 = *(const LAS3 f32x4*)(wfb + (k + j) * 8), w1 = *(const LAS3 f32x4*)(wfb + (k + j) * 8 + 4);
                fa[0] += y[j] * w0[0]; fa[1] += y[j] * w0[1]; fa[2] += y[j] * w0[2]; fa[3] += y[j] * w0[3]; fa[4] += y[j] * w1[0]; fa[5] += y[j] * w1[1]; fa[6] += y[j] * w1[2]; fa[7] += y[j] * w1[3]; } }
#pragma unroll
        for (int e = 0; e < 8; ++e) fa[e] = wave_sum(fa[e]);
        float mine = fa[0];
#pragma unroll
        for (int e = 1; e < 8; ++e) mine = (lane == e) ? fa[e] : mine;
        if (lane < 8) { const float z = mine + p.b_forget[lane]; const float lf = -(fmaxf(-z, 0.f) + log1pf(expf(-fabsf(z))));
            const int b = row / S, s = row % S; LOGF[(size_t)(b * 8 + lane) * S + s] = lf; }
#pragma unroll
        for (int i = 0; i < 4; ++i) v[i] = nv[i];
    }
    bf16_t* HM = (bf16_t*)(ws + OFF_HM);
    for (int row = bid * 8 + wid; row < NB * NMEM; row += G * 8) {
        const float* xr = p.mem + (size_t)row * DM; f32x4 v[4]; float ss = 0.f;
#pragma unroll
        for (int i = 0; i < 4; ++i) { v[i] = *(const f32x4*)(xr + 4 * lane + 256 * i); ss += v[i][0] * v[i][0] + v[i][1] * v[i][1] + v[i][2] * v[i][2] + v[i][3] * v[i][3]; }
        ss = wave_sum(ss); const float rstd = rsqrtf(ss * (1.0f / DM) + EPS);
#pragma unroll
        for (int i = 0; i < 4; ++i) { const int k = 4 * lane + 256 * i; const f32x4 g = *(const f32x4*)(p.g_mem + k); f32x4 y = v[i] * rstd * g;
            u32x2 w; w.x = pk_bf16(y[0], y[1]); w.y = pk_bf16(y[2], y[3]); *(u32x2*)(HM + (size_t)row * DM + k) = w; }
    }
    __syncthreads();
}

__device__ void scan_logf(const Params& p, LAS3 unsigned char* lds) {
    int tid = threadIdx.x; asm volatile("" : "+v"(tid)); const int lane = tid & 63, wid = tid >> 6;
    size_t wz = 0; asm volatile("" : "+s"(wz)); unsigned char* ws = p.ws + wz;
    const float* LOGF = (const float*)(ws + OFF_LOGF); float* CB2 = (float*)(ws + OFF_CB2);
    LAS3 float* wt = (LAS3 float*)lds;
    for (int bh = (int)blockIdx.x - 32 + ((int)blockIdx.x < 32 ? (int)gridDim.x : 0); bh < 64; bh += gridDim.x) {
        const float* src = LOGF + (size_t)bh * S + tid * 16; f32x4 v[4];
#pragma unroll
        for (int i = 0; i < 4; ++i) v[i] = *(const f32x4*)(src + 4 * i);
        float run = 0.f;
#pragma unroll
        for (int i = 0; i < 4; ++i)
#pragma unroll
            for (int j = 0; j < 4; ++j) { run += v[i][j]; v[i][j] = run; }
        float inc = run;
#pragma unroll
        for (int o = 1; o < 64; o <<= 1) { const float t = __shfl_up(inc, o); if (lane >= o) inc += t; }
        if (lane == 63) wt[wid] = inc;
        __syncthreads();
        float base = inc - run;
        for (int w = 0; w < wid; ++w) base += wt[w];
        float* dst = CB2 + (size_t)bh * S + tid * 16;
#pragma unroll
        for (int i = 0; i < 4; ++i) { f32x4 o = (v[i] + base) * (-LOG2E); *(f32x4*)(dst + 4 * i) = o; }
        __syncthreads();
    }
}
using pg8::Unit;
struct EpiP1 {
    static constexpr bool PERM = true, AFTER_DRAIN = false;
    bf16_t* O; int ldc; const int* pos; int mode; unsigned* nrm;
    __device__ __forceinline__ void operator()(f32x4 (&acc)[2][2][4][2], const Unit& u, int wr, int wc, int fr, int fq, int lane) const {
        const int row0 = u.pm * 256 + wr * 64 + fr, colb = u.pn * 256 + wc * 32 + 8 * fq;
        float sc = 1.f; bool rope = false;
        if (mode == 0) { if (u.pn < 6 || u.pn >= 24) sc = SC128; else if (u.pn == 18 || u.pn == 19) sc = SC64; rope = (u.pn < 12) && (wc == 0); }
        if (rope) {
            const float sgn = fq < 2 ? -1.f : 1.f; float inv[8];
#pragma unroll
            for (int e = 0; e < 8; ++e) inv[e] = __builtin_amdgcn_exp2f(-(float)(8 * (fq & 1) + e) * (18.931568569324174f / 16.0f)) * 0.15915494309189535f;
#pragma unroll
            for (int ai = 0; ai < 2; ++ai)
#pragma unroll
                for (int m = 0; m < 4; ++m) { const float pp = (float)pos[row0 + ai * 128 + m * 16];
#pragma unroll
                    for (int n = 0; n < 2; ++n)
#pragma unroll
                        for (int j = 0; j < 4; ++j) { const float fr_ = __builtin_amdgcn_fractf(pp * inv[4 * n + j]);
                            const float sn = __builtin_amdgcn_sinf(fr_) * sgn, cs = __builtin_amdgcn_cosf(fr_);
#pragma unroll
                            for (int bj = 0; bj < 2; ++bj) { const float v = acc[ai][bj][m][n][j]; const float pv = __shfl_xor(v, 32); acc[ai][bj][m][n][j] = v * cs + pv * sn; } }
                    __builtin_amdgcn_sched_barrier(0); }
        }
        if (mode == 0 && u.pn >= 18 && u.pn <= 21) {
            const int kind = u.pn >= 20 ? 1 : 0, bb = (u.pm * 256) >> 13;
#pragma unroll
            for (int bj = 0; bj < 2; ++bj) { float mxs = 0.f;
#pragma unroll
                for (int ai = 0; ai < 2; ++ai)
#pragma unroll
                    for (int m = 0; m < 4; ++m) { const f32x4 a0 = acc[ai][bj][m][0], a1 = acc[ai][bj][m][1];
                        float ss = (a0[0] * a0[0] + a0[1] * a0[1]) + (a0[2] * a0[2] + a0[3] * a0[3]) + (a1[0] * a1[0] + a1[1] * a1[1]) + (a1[2] * a1[2] + a1[3] * a1[3]);
                        ss += __shfl_xor(ss, 16); ss += __shfl_xor(ss, 32); mxs = fmaxf(mxs, ss); }
                mxs = fmaxf(mxs, __shfl_xor(mxs, 1)); mxs = fmaxf(mxs, __shfl_xor(mxs, 2)); mxs = fmaxf(mxs, __shfl_xor(mxs, 4)); mxs = fmaxf(mxs, __shfl_xor(mxs, 8));
                const int hd = (u.pn & 1) * 4 + 2 * bj + (wc >> 1);
                if (lane == 0) atomicMax(nrm + (kind ? 4096 + ((bb * 8 + hd) * 2 + (wc & 1)) : (((bb * 8 + hd) * 32 + (u.pm & 31)) * 2 + (wc & 1))), __float_as_uint(mxs * sc * sc)); }
            __builtin_amdgcn_sched_barrier(0);
        }
#pragma unroll
        for (int ai = 0; ai < 2; ++ai)
#pragma unroll
            for (int m = 0; m < 4; ++m) { bf16_t* rowp = O + (size_t)(row0 + ai * 128 + m * 16) * ldc + colb;
#pragma unroll
                for (int bj = 0; bj < 2; ++bj) { const f32x4 v0 = acc[ai][bj][m][0] * sc, v1 = acc[ai][bj][m][1] * sc; u32x4 w;
                    w.x = pk_bf16(v0[0], v0[1]); w.y = pk_bf16(v0[2], v0[3]); w.z = pk_bf16(v1[0], v1[1]); w.w = pk_bf16(v1[2], v1[3]); *(u32x4*)(rowp + bj * 128) = w; } }
    }
};
__device__ __forceinline__ void unpack8(const u32x4 w, float (&f)[8]) { f[0] = bf_lo(w.x); f[1] = bf_hi(w.x); f[2] = bf_lo(w.y); f[3] = bf_hi(w.y); f[4] = bf_lo(w.z); f[5] = bf_hi(w.z); f[6] = bf_lo(w.w); f[7] = bf_hi(w.w); }
__device__ __forceinline__ u32x4 pack8(const float (&f)[8]) { u32x4 w; w.x = pk_bf16(f[0], f[1]); w.y = pk_bf16(f[2], f[3]); w.z = pk_bf16(f[4], f[5]); w.w = pk_bf16(f[6], f[7]); return w; }
struct EpiZ {
    static constexpr bool PERM = true, AFTER_DRAIN = false;
    bf16_t* U; const float* lse; int row_base;
    __device__ __forceinline__ void operator()(f32x4 (&acc)[2][2][4][2], const Unit& u, int wr, int wc, int fr, int fq, int lane) const {
        const int zt = u.pn >> 1;
#pragma unroll
        for (int ai = 0; ai < 2; ++ai)
#pragma unroll
            for (int m = 0; m < 4; ++m) { const unsigned row = ai * 128 + wr * 64 + m * 16 + fr;
#pragma unroll
                for (int bj = 0; bj < 2; ++bj) { const int cbr = (u.pn & 1) * 256 + bj * 128 + wc * 32 + 8 * fq;
                    float w0 = 1.f, w1 = 0.f, w2 = 0.f;
                    if (zt == 0) { const int head = cbr >> 7; const float l0 = lse[row * 12 + head], l1 = lse[row * 12 + 4 + head], l2 = lse[row * 12 + 8 + head];
                        const float mx = fmaxf(l0, fmaxf(l1, l2)); w0 = __builtin_amdgcn_exp2f(l0 - mx); w1 = __builtin_amdgcn_exp2f(l1 - mx); w2 = __builtin_amdgcn_exp2f(l2 - mx);
                        const float rs = __builtin_amdgcn_rcpf(w0 + w1 + w2); w0 *= rs; w1 *= rs; w2 *= rs; }
                    bf16_t* ptr = U + (row * (unsigned)UP + (unsigned)((zt == 0 ? 0 : (zt == 1 ? C_QB : C_QM)) + cbr));
                    { float v[8]; unpack8(*(const u32x4*)ptr, v);
                      if (zt == 0) { float v1[8], v2[8]; unpack8(*(const u32x4*)(ptr + 512), v1); unpack8(*(const u32x4*)(ptr + 1024), v2);
#pragma unroll
                          for (int e = 0; e < 8; ++e) v[e] = w0 * v[e] + w1 * v1[e] + w2 * v2[e]; }
#pragma unroll
                      for (int j = 0; j < 4; ++j) { v[j] *= silu_f(acc[ai][bj][m][0][j]); v[4 + j] *= silu_f(acc[ai][bj][m][1][j]); }
                      *(u32x4*)ptr = pack8(v); }
                    __builtin_amdgcn_sched_barrier(0); } }
    }
};
struct EpiG {
    static constexpr bool PERM = true, AFTER_DRAIN = false;
    bf16_t* Gt; const float* bias; int ld;
    __device__ __forceinline__ void operator()(f32x4 (&acc)[2][2][4][2], const Unit& u, int wr, int wc, int fr, int fq, int lane) const {
#pragma unroll
        for (int bj = 0; bj < 2; ++bj) { const int c8 = u.pn * 256 + bj * 128 + wc * 32 + 8 * fq; const f32x4 b0 = *(const f32x4*)(bias + c8), b1 = *(const f32x4*)(bias + c8 + 4);
#pragma unroll
            for (int ai = 0; ai < 2; ++ai)
#pragma unroll
                for (int m = 0; m < 4; ++m) { const int rl = ai * 128 + wr * 64 + m * 16 + fr; float z[8];
#pragma unroll
                    for (int j = 0; j < 4; ++j) { z[j] = sigmoid_f(acc[ai][bj][m][0][j] + b0[j]); z[4 + j] = sigmoid_f(acc[ai][bj][m][1][j] + b1[j]); }
                    *(u32x4*)(Gt + ((unsigned)rl * (unsigned)ld + (unsigned)c8)) = pack8(z); } }
    }
};
struct EpiBr {
    static constexpr bool PERM = true, AFTER_DRAIN = false;
    bf16_t* Mg; const bf16_t* Gt; int first; int jj; int ld; int ldg;
    __device__ __forceinline__ void operator()(f32x4 (&acc)[2][2][4][2], const Unit& u, int wr, int wc, int fr, int fq, int lane) const {
#pragma unroll
        for (int ai = 0; ai < 2; ++ai)
#pragma unroll
            for (int m = 0; m < 4; ++m) { const int rl = ai * 128 + wr * 64 + m * 16 + fr;
#pragma unroll
                for (int bj = 0; bj < 2; ++bj) { const int c8 = u.pn * 256 + bj * 128 + wc * 32 + 8 * fq; const unsigned off = (unsigned)rl * (unsigned)ld + (unsigned)c8;
                    float g[8], z[8]; unpack8(*(const u32x4*)(Gt + ((unsigned)rl * (unsigned)ldg + (unsigned)c8)), g);
#pragma unroll
                    for (int j = 0; j < 4; ++j) { z[j] = acc[ai][bj][m][0][j] * g[j]; z[4 + j] = acc[ai][bj][m][1][j] * g[4 + j]; }
#ifdef DBG_ZERO_BR
                    if (jj == DBG_ZERO_BR) { for (int j = 0; j < 8; ++j) z[j] = 0.f; }
#endif
                    if (!first) { float o[8]; unpack8(*(const u32x4*)(Mg + off), o);
#pragma unroll
                        for (int j = 0; j < 8; ++j) z[j] += o[j]; }
                    *(u32x4*)(Mg + off) = pack8(z); } }
    }
};
struct EpiOut {
    static constexpr bool PERM = true, AFTER_DRAIN = false;
    bf16_t* U; LAS3 float* ssp; int row_base;
    __device__ __forceinline__ void operator()(f32x4 (&acc)[2][2][4][2], const Unit& u, int wr, int wc, int fr, int fq, int lane) const {
#pragma unroll
        for (int ai = 0; ai < 2; ++ai)
#pragma unroll
            for (int m = 0; m < 4; ++m) { const unsigned row = ai * 128 + wr * 64 + m * 16 + fr; float ss = 0.f;
#pragma unroll
                for (int bj = 0; bj < 2; ++bj) { const int c8 = u.pn * 256 + bj * 128 + wc * 32 + 8 * fq; float z[8];
#pragma unroll
                    for (int j = 0; j < 4; ++j) { z[j] = acc[ai][bj][m][0][j]; z[4 + j] = acc[ai][bj][m][1][j]; }
#pragma unroll
                    for (int j = 0; j < 8; ++j) ss += z[j] * z[j];
                    *(u32x4*)(U + (row * (unsigned)UP + (unsigned)(C_OUT + c8))) = pack8(z); }
                ss += __shfl_xor(ss, 16); ss += __shfl_xor(ss, 32);
                if (fq == 0) ssp[row * 16 + u.pn * 4 + wc] = ss;
                __builtin_amdgcn_sched_barrier(0); }
    }
};
struct EpiZG {
    static constexpr bool PERM = true, AFTER_DRAIN = false;
    EpiZ z; EpiG g;
    __device__ __forceinline__ void operator()(f32x4 (&acc)[2][2][4][2], const Unit& u, int wr, int wc, int fr, int fq, int lane) const {
        if (u.pn < 6) z(acc, u, wr, wc, fr, fq, lane);
        else { Unit u2; u2.pm = u.pm; u2.pn = u.pn - 6; g(acc, u2, wr, wc, fr, fq, lane); }
    }
};
struct PanelOrder {
    int pm_a, n0, cnt;
    __device__ __forceinline__ bool next(int i, Unit& u) const { if (i >= cnt) return false; u.pm = pm_a; u.pn = n0 + i; return true; }
    __device__ __forceinline__ void a_ready(const Unit&) const {}
    __device__ __forceinline__ void done(const Unit&) const {}
};

namespace at128 {
constexpr int KROW = 272, VROW = 288, LDS_K = 0, LDS_V = 256 * KROW, LDS_TOTAL = LDS_V + 256 * VROW;
typedef short v4i16_t __attribute__((ext_vector_type(4)));
struct UArgs { bf16_t* Qp; long q_rs; const bf16_t* Kp; const bf16_t* Vp; long k_rs; int klo; float* lsep; long lse_rs; };
__device__ __forceinline__ void issue_band(const UArgs& a, int tid, u32x4 (&kreg)[8], u32x4 (&vreg)[8]) {
#pragma unroll
    for (int i = 0; i < 8; ++i) { const int c = tid + 512 * i, row = c >> 4, ch = c & 15; kreg[i] = (u32x4){0u, 0u, 0u, 0u}; vreg[i] = (u32x4){0u, 0u, 0u, 0u};
        if (row >= a.klo) { kreg[i] = *(const u32x4*)(a.Kp + (long)row * a.k_rs + ch * 8); vreg[i] = *(const u32x4*)(a.Vp + (long)row * a.k_rs + ch * 8); } }
}
template <bool BAND>
__device__ __forceinline__ void unit(LAS3 unsigned char* lds, const UArgs& cur, u32x4 (&kreg)[8], u32x4 (&vreg)[8], bool has_next, const UArgs& nxt, bool restage = true, bool endsync = true) {
    bf16_t* Qp = cur.Qp; const long q_rs = cur.q_rs; const int klo = cur.klo; float* lsep = cur.lsep; const long lse_rs = cur.lse_rs;
    int tid = threadIdx.x; asm volatile("" : "+v"(tid));
    const int lane = tid & 63, w = __builtin_amdgcn_readfirstlane(tid >> 6), qi = lane & 15, g = lane >> 4;
    if (restage) {
#pragma unroll
    for (int i = 0; i < 8; ++i) { const int c = tid + 512 * i, row = c >> 4, ch = c & 15;
        *(LAS3 u32x4*)(lds + LDS_K + row * KROW + ch * 16) = kreg[i]; *(LAS3 u32x4*)(lds + LDS_V + row * VROW + ch * 16) = vreg[i]; } }
    const int qrow = 16 * w + qi; bf16_t* qptr = Qp + (long)qrow * q_rs;
    bf16x8 qf[4];
#pragma unroll
    for (int s = 0; s < 4; ++s) qf[s] = *(const bf16x8*)(qptr + 32 * s + 8 * g);
    if (restage) __syncthreads();
    if (has_next) issue_band(nxt, tid, kreg, vreg);
    constexpr int NT = BAND ? 10 : 16; const int jb = BAND ? w : 0;
    f32x4 st[NT];
#pragma unroll
    for (int jt = 0; jt < NT; ++jt) {
        if (BAND && jt == 9) { st[jt] = (f32x4){-1e30f, -1e30f, -1e30f, -1e30f}; continue; }
        const int j = jb + jt; f32x4 a = (f32x4){0.f, 0.f, 0.f, 0.f};
        const LAS3 unsigned char* kp = lds + LDS_K + (16 * j + qi) * KROW + 16 * g;
#pragma unroll
        for (int s = 0; s < 4; ++s) { const bf16x8 kf = *(const LAS3 bf16x8*)(kp + 64 * s); a = __builtin_amdgcn_mfma_f32_16x16x32_bf16(kf, qf[s], a, 0, 0, 0); }
        if (BAND) { const int qidx = 16 * w + qi;
#pragma unroll
            for (int i = 0; i < 4; ++i) { const int ki = 16 * j + 4 * g + i; const bool ok = (ki >= qidx) && (ki <= qidx + 128) && (ki >= klo); a[i] = ok ? a[i] : -1e30f; } }
        st[jt] = a;
    }
    float mx = -1e30f;
#pragma unroll
    for (int jt = 0; jt < NT; ++jt) mx = fmaxf(mx, fmaxf(fmaxf(st[jt][0], st[jt][1]), fmaxf(st[jt][2], st[jt][3])));
    mx = fmaxf(mx, __shfl_xor(mx, 16)); mx = fmaxf(mx, __shfl_xor(mx, 32));
    float sum = 0.f;
#pragma unroll
    for (int jt = 0; jt < NT; ++jt) {
#pragma unroll
        for (int i = 0; i < 4; ++i) { const float e = __builtin_amdgcn_exp2f(st[jt][i] - mx); st[jt][i] = e; sum += e; } }
    sum += __shfl_xor(sum, 16); sum += __shfl_xor(sum, 32);
    f32x4 o[8];
#pragma unroll
    for (int c = 0; c < 8; ++c) o[c] = (f32x4){0.f, 0.f, 0.f, 0.f};
#pragma unroll
    for (int pp = 0; pp < NT / 2; ++pp) {
        int j0 = jb + 2 * pp, j1 = j0 + 1; if (j1 > 15) j1 = 15;
        u32x4 pw; pw.x = pk_bf16(st[2 * pp][0], st[2 * pp][1]); pw.y = pk_bf16(st[2 * pp][2], st[2 * pp][3]); pw.z = pk_bf16(st[2 * pp + 1][0], st[2 * pp + 1][1]); pw.w = pk_bf16(st[2 * pp + 1][2], st[2 * pp + 1][3]);
        const bf16x8 pf = __builtin_bit_cast(bf16x8, pw);
        const int q4 = qi >> 2, p4 = qi & 3;
        const LAS3 unsigned char* v0 = lds + LDS_V + (16 * j0 + 4 * g + q4) * VROW + 8 * p4;
        const LAS3 unsigned char* v1 = lds + LDS_V + (16 * j1 + 4 * g + q4) * VROW + 8 * p4;
#pragma unroll
        for (int c = 0; c < 8; ++c) {
            const v4i16_t lo = __builtin_amdgcn_ds_read_tr16_b64_v4i16((LAS3 v4i16_t*)(v0 + 32 * c));
            const v4i16_t hi = __builtin_amdgcn_ds_read_tr16_b64_v4i16((LAS3 v4i16_t*)(v1 + 32 * c));
            const bf16x8 vf = (bf16x8){lo[0], lo[1], lo[2], lo[3], hi[0], hi[1], hi[2], hi[3]};
            o[c] = __builtin_amdgcn_mfma_f32_16x16x32_bf16(vf, pf, o[c], 0, 0, 0);
        }
    }
    const float rinv = __builtin_amdgcn_rcpf(sum);
#pragma unroll
    for (int c = 0; c < 8; ++c) { const f32x4 v = o[c] * rinv; u32x2 wv; wv.x = pk_bf16(v[0], v[1]); wv.y = pk_bf16(v[2], v[3]); *(u32x2*)(qptr + 16 * c + 4 * g) = wv; }
    if (lsep && g == 0) lsep[(long)qrow * lse_rs] = mx + __builtin_amdgcn_logf(sum);
    if (endsync) __syncthreads();
}

template <bool BAND>
__device__ void unit_naive(bf16_t* Qp, long q_rs, const bf16_t* Kp, const bf16_t* Vp, long k_rs, int klo, float* lsep, long lse_rs) {
    int tid = threadIdx.x; asm volatile("" : "+v"(tid)); const int lane = tid & 63, w = tid >> 6;
    for (int qrow = w; qrow < 128; qrow += 8) {
        bf16_t* qptr = Qp + (long)qrow * q_rs; float lg[4]; int kidx[4]; bool ok[4];
#pragma unroll
        for (int i = 0; i < 4; ++i) { const int n = lane + 64 * i; kidx[i] = BAND ? qrow + n : n; ok[i] = BAND ? (n <= 128 && kidx[i] >= klo) : true;
            float a = 0.f;
            if (ok[i]) { const bf16_t* kp = Kp + (long)kidx[i] * k_rs;
                for (int c = 0; c < 16; ++c) { const u32x4 qa = *(const u32x4*)(qptr + 8 * c), ka = *(const u32x4*)(kp + 8 * c);
                    a += bf_lo(qa.x) * bf_lo(ka.x) + bf_hi(qa.x) * bf_hi(ka.x) + bf_lo(qa.y) * bf_lo(ka.y) + bf_hi(qa.y) * bf_hi(ka.y) + bf_lo(qa.z) * bf_lo(ka.z) + bf_hi(qa.z) * bf_hi(ka.z) + bf_lo(qa.w) * bf_lo(ka.w) + bf_hi(qa.w) * bf_hi(ka.w); } }
            lg[i] = ok[i] ? a : -1e30f; }
        float mx = fmaxf(fmaxf(lg[0], lg[1]), fmaxf(lg[2], lg[3]));
#pragma unroll
        for (int of = 32; of >= 1; of >>= 1) mx = fmaxf(mx, __shfl_xor(mx, of));
        float sum = 0.f;
#pragma unroll
        for (int i = 0; i < 4; ++i) { lg[i] = ok[i] ? __builtin_amdgcn_exp2f(lg[i] - mx) : 0.f; sum += lg[i]; }
        sum = wave_sum(sum);
        float o0 = 0.f, o1 = 0.f; const int nk = BAND ? 129 : 256;
        for (int n = 0; n < nk; ++n) { const int i = n >> 6; const float pv = __shfl(i == 0 ? lg[0] : (i == 1 ? lg[1] : (i == 2 ? lg[2] : lg[3])), n & 63);
            const int ki = BAND ? qrow + n : n; if (BAND && ki < klo) continue;
            const unsigned vv = *(const unsigned*)(Vp + (long)ki * k_rs + 2 * lane); o0 += pv * bf_lo(vv); o1 += pv * bf_hi(vv); }
        const float ri = 1.0f / sum;
        *(unsigned*)(qptr + 2 * lane) = pk_bf16(o0 * ri, o1 * ri);
        if (lsep && lane == 0) lsep[(long)qrow * lse_rs] = mx + __builtin_amdgcn_logf(sum);
    }
}
}

__device__ void fox_naive(bf16_t* U, const float* CB2) {
    int tid = threadIdx.x; asm volatile("" : "+v"(tid)); const int lane = tid & 63, wid = tid >> 6;
    for (long qi = (long)blockIdx.x * 8 + wid; qi < (long)NTOK * 8; qi += (long)gridDim.x * 8) {
        const int h = (int)(qi & 7); const long row = qi >> 3; const int b = (int)(row / S), t = (int)(row % S);
        const bf16_t* qp = U + row * UP + C_QB + h * 64; const float* cb = CB2 + (size_t)(b * 8 + h) * S;
        float q[64];
#pragma unroll
        for (int c = 0; c < 8; ++c) { const u32x4 w = *(const u32x4*)(qp + 8 * c); q[8*c] = bf_lo(w.x); q[8*c+1] = bf_hi(w.x); q[8*c+2] = bf_lo(w.y); q[8*c+3] = bf_hi(w.y); q[8*c+4] = bf_lo(w.z); q[8*c+5] = bf_hi(w.z); q[8*c+6] = bf_lo(w.w); q[8*c+7] = bf_hi(w.w); }
        float m = -1e30f, l = 0.f; float o[64];
#pragma unroll
        for (int d = 0; d < 64; ++d) o[d] = 0.f;
        for (int s0 = lane; s0 <= t; s0 += 64) {
            const bf16_t* kp = U + ((long)b * S + s0) * UP + C_KB + h * 64; const bf16_t* vp = U + ((long)b * S + s0) * UP + C_VB + h * 64;
            float x = 0.f;
#pragma unroll
            for (int c = 0; c < 8; ++c) { const u32x4 w = *(const u32x4*)(kp + 8 * c);
                x += q[8*c] * bf_lo(w.x) + q[8*c+1] * bf_hi(w.x) + q[8*c+2] * bf_lo(w.y) + q[8*c+3] * bf_hi(w.y) + q[8*c+4] * bf_lo(w.z) + q[8*c+5] * bf_hi(w.z) + q[8*c+6] * bf_lo(w.w) + q[8*c+7] * bf_hi(w.w); }
            x += cb[s0];
            const float mn = fmaxf(m, x), f = __builtin_amdgcn_exp2f(m - mn), pz = __builtin_amdgcn_exp2f(x - mn); m = mn; l = l * f + pz;
#pragma unroll
            for (int c = 0; c < 8; ++c) { const u32x4 w = *(const u32x4*)(vp + 8 * c);
                o[8*c] = o[8*c] * f + pz * bf_lo(w.x); o[8*c+1] = o[8*c+1] * f + pz * bf_hi(w.x); o[8*c+2] = o[8*c+2] * f + pz * bf_lo(w.y); o[8*c+3] = o[8*c+3] * f + pz * bf_hi(w.y);
                o[8*c+4] = o[8*c+4] * f + pz * bf_lo(w.z); o[8*c+5] = o[8*c+5] * f + pz * bf_hi(w.z); o[8*c+6] = o[8*c+6] * f + pz * bf_lo(w.w); o[8*c+7] = o[8*c+7] * f + pz * bf_hi(w.w); }
        }
        float mg = m;
#pragma unroll
        for (int of = 32; of >= 1; of >>= 1) mg = fmaxf(mg, __shfl_xor(mg, of));
        const float sc = __builtin_amdgcn_exp2f(m - mg); l = wave_sum(l * sc); const float rl = 1.0f / l;
        float mine0 = 0.f;
#pragma unroll
        for (int d = 0; d < 64; ++d) { const float v = wave_sum(o[d] * sc) * rl; mine0 = (lane == d) ? v : mine0; }
        const float nb = __shfl_xor(mine0, 1);
        if ((lane & 1) == 0) *(unsigned*)((bf16_t*)qp + lane) = pk_bf16(mine0, nb);
    }
}
__device__ void phase1(const Params& p, LAS3 unsigned char* lds) {
    size_t wz = 0; asm volatile("" : "+s"(wz)); unsigned char* ws = p.ws + wz;
    scan_logf(p, lds);
    { pg8::Gemm g{(const bf16_t*)(ws + OFF_H), (const bf16_t*)(ws + OFF_WT), NTOK, UP, DM, DM}; pg8::StaticOrder S; S.init(NTOK, UP, (int)gridDim.x, (int)blockIdx.x);
      EpiP1 E{(bf16_t*)(ws + OFF_U), UP, p.pos, 0, (unsigned*)(ws + OFF_ROWSS)};
      pg8::gemm_phase<EpiP1, pg8::StaticOrder, true, true>(lds, g, S, E); }
#ifdef MKV_NAIVE
    { int tid = threadIdx.x; asm volatile("" : "+v"(tid)); const bf16_t* HM = (const bf16_t*)(ws + OFF_HM); bf16_t* MKV = (bf16_t*)(ws + OFF_MKV);
      for (int e = blockIdx.x * 512 + tid; e < NB * NMEM * 1024; e += gridDim.x * 512) { const int row = e >> 10, col = e & 1023; float a = 0.f;
          for (int k = 0; k < 1024; ++k) a += __uint_as_float((unsigned)HM[(size_t)row * 1024 + k] << 16) * p.w_mem_kv[(size_t)k * 1024 + col];
          MKV[e] = (bf16_t)(pk_bf16(a, 0.f) & 0xffffu); } }
#else
    { pg8::Gemm g{(const bf16_t*)(ws + OFF_HM), (const bf16_t*)(ws + OFF_WMEM), NB * NMEM, 1024, DM, DM}; pg8::StaticOrder S; S.init(NB * NMEM, 1024, (int)gridDim.x, (int)blockIdx.x);
      EpiP1 E{(bf16_t*)(ws + OFF_MKV), 1024, p.pos, 1, (unsigned*)(ws + OFF_ROWSS)};
      pg8::gemm_phase<EpiP1, pg8::StaticOrder, true, true>(lds, g, S, E); }
#endif
}
#ifdef A_NAIVE
#define AT_UNIT_A(...) at128::unit_naive<true>(__VA_ARGS__)
#else
#define AT_UNIT_A(...) at128::unit<true>(lds, __VA_ARGS__)
#endif
#ifdef M_NAIVE
#define AT_UNIT_M(...) at128::unit_naive<false>(__VA_ARGS__)
#else
#define AT_UNIT_M(...) at128::unit<false>(lds, __VA_ARGS__)
#endif
__device__ void phase2(const Params& p, LAS3 unsigned char* lds) {
    size_t wz = 0; asm volatile("" : "+s"(wz)); unsigned char* ws = p.ws + wz;   bf16_t* U = (bf16_t*)(ws + OFF_U);
#ifdef FOX_NAIVE
    fox_naive(U, (const float*)(ws + OFF_CB2));
#elif !defined(NO_FOX)
    { const attn_body::AttnTensors AT{(const attn_body::bf16*)(U + C_QB), (const attn_body::bf16*)(U + C_KB), (const attn_body::bf16*)(U + C_VB), (attn_body::bf16*)(U + C_QB), (const float*)(ws + OFF_CB2), (const float*)(ws + OFF_ROWSS)};
      const attn_body::StaticOrder SO((int)gridDim.x, (int)blockIdx.x);
      attn_body::attn_phase<attn_body::StaticOrder>((char*)lds, AT, SO); }
#endif
    __syncthreads();
#ifndef NO_AT128
    float* LSE = (float*)(ws + OFF_LSE);
    {
      auto decA = [&](int a0) { const int a = (a0 & 7) * 768 + (a0 >> 3);     const int b = a / 768, rem = a % 768, hh = rem >> 6, blk = rem & 63, grp = hh >> 2, dil = 1 << (2 * grp), nb = 64 >> (2 * grp), r = blk / nb, n = blk % nb;
          const long qrow0 = (long)b * S + (long)(128 * n) * dil + r, krow0 = qrow0 - 128L * dil;
          return at128::UArgs{U + qrow0 * UP + C_QA + hh * 128, (long)dil * UP, U + krow0 * UP + C_KA + hh * 128, U + krow0 * UP + C_VA + hh * 128, (long)dil * UP, n == 0 ? 128 : 0, LSE + qrow0 * 12 + hh, (long)dil * 12}; };
      u32x4 kreg[8], vreg[8]; int tid0 = threadIdx.x; asm volatile("" : "+v"(tid0)); int a = blockIdx.x;
      if (a < 6144) { at128::UArgs cur = decA(a); at128::issue_band(cur, tid0, kreg, vreg);
          for (; a < 6144; a += gridDim.x) { const int an = a + gridDim.x; const bool has = an < 6144; const at128::UArgs nxt = decA(has ? an : a);
              at128::unit<true>(lds, cur, kreg, vreg, has, nxt); cur = nxt; } } }
    const bf16_t* MKV = (const bf16_t*)(ws + OFF_MKV);
    { auto decM = [&](int a0) { const int a = (a0 & 7) * 256 + (a0 >> 3);     const int b = a >> 8, rem = a & 255, h = rem >> 6, n = rem & 63; const long qrow0 = (long)b * S + 128 * n;
          return at128::UArgs{U + qrow0 * UP + C_QM + h * 128, (long)UP, MKV + (long)b * NMEM * 1024 + h * 128, MKV + (long)b * NMEM * 1024 + 512 + h * 128, 1024L, 0, nullptr, 0}; };
      u32x4 kreg[8], vreg[8]; int tid0 = threadIdx.x; asm volatile("" : "+v"(tid0)); int a = blockIdx.x;
      if (gridDim.x == 256) {
          const int c = (int)blockIdx.x, b = c & 7, cc = c >> 3, h = cc >> 3, n0 = (cc & 7) * 8;
          at128::UArgs cur{U + ((long)b * S + 128L * n0) * UP + C_QM + h * 128, (long)UP, MKV + (long)b * NMEM * 1024 + h * 128, MKV + (long)b * NMEM * 1024 + 512 + h * 128, 1024L, 0, nullptr, 0};
          at128::issue_band(cur, tid0, kreg, vreg);
          for (int k = 0; k < 8; ++k) { at128::unit<false>(lds, cur, kreg, vreg, false, cur, k == 0, k == 7); cur.Qp += 128L * UP; }
      } else
      if (a < 2048) { at128::UArgs cur = decM(a); at128::issue_band(cur, tid0, kreg, vreg);
          for (; a < 2048; a += gridDim.x) { const int an = a + gridDim.x; const bool has = an < 2048; const at128::UArgs nxt = decM(has ? an : a);
              at128::unit<false>(lds, cur, kreg, vreg, has, nxt); cur = nxt; } } }
#endif
}
__device__ void phase3(const Params& p, LAS3 unsigned char* lds) {
    size_t wz = 0; asm volatile("" : "+s"(wz)); unsigned char* ws = p.ws + wz;   bf16_t* U = (bf16_t*)(ws + OFF_U); const bf16_t* H = (const bf16_t*)(ws + OFF_H); const bf16_t* WT = (const bf16_t*)(ws + OFF_WT);
    for (int pm = blockIdx.x; pm < NTOK / 256; pm += gridDim.x) {
        bf16_t* Mg = (bf16_t*)((unsigned char*)p.out + (size_t)pm * MiB); bf16_t* Gt = Mg + 256 * 1024; constexpr int TP = 1024;
#ifdef DBG_GT0
        Gt = U + (size_t)pm * 256 * UP;
#endif
        bf16_t* Gall = U + (size_t)pm * 256 * UP + C_KA;
        { pg8::Gemm g{H, WT + (size_t)6656 * 1024, NTOK, 4608, DM, DM}; PanelOrder S{pm, 0, 18};
          EpiZG E{EpiZ{U + (size_t)pm * 256 * UP, (const float*)(ws + OFF_LSE) + (size_t)pm * 256 * 12, pm * 256}, EpiG{Gall, p.b_merge, UP}};
          pg8::gemm_phase<EpiZG, PanelOrder, true, true>(lds, g, S, E); }
        blk_sync_mem();
#if defined(DBG_STAGE) && DBG_STAGE == 1
        { int t4 = threadIdx.x; const int lane = t4 & 63, wid = t4 >> 6;
          for (int rl = wid; rl < 256; rl += 8) { const size_t row = (size_t)pm * 256 + rl;
              for (int i = 0; i < 4; ++i) { const int k = 4 * lane + 256 * i; const u32x2 w = *(const u32x2*)(U + row * UP + DBG_COL + k); const f32x4 xv = *(const f32x4*)(p.x + row * DM + k);
                  f32x4 o; o[0] = xv[0] + bf_lo(w.x); o[1] = xv[1] + bf_hi(w.x); o[2] = xv[2] + bf_lo(w.y); o[3] = xv[3] + bf_hi(w.y); *(f32x4*)(p.out + row * DM + k) = o; } }
          continue; }
#endif
#ifdef P3_NAIVE
        {
          int t4 = threadIdx.x; asm volatile("" : "+v"(t4)); const int c0 = 2 * t4; LAS3 float* mrg = (LAS3 float*)lds; LAS3 float* red = mrg + 4 * 1024;
          for (int r0 = 0; r0 < 256; r0 += 4) {
              float mg[4][2];
              for (int r = 0; r < 4; ++r) { mg[r][0] = 0.f; mg[r][1] = 0.f; }
              for (int j = 0; j < 3; ++j) {
                  float ga[4][2], br[4][2];
                  for (int r = 0; r < 4; ++r) { ga[r][0] = ga[r][1] = br[r][0] = br[r][1] = 0.f; }
                  for (int k = 0; k < 1024; ++k) { const float w0 = p.w_in[(size_t)k * IN_COLS + 8200 + j * 1024 + c0], w1 = p.w_in[(size_t)k * IN_COLS + 8200 + j * 1024 + c0 + 1];
#pragma unroll
                      for (int r = 0; r < 4; ++r) { const float hv = __uint_as_float((unsigned)H[((size_t)pm * 256 + r0 + r) * 1024 + k] << 16); ga[r][0] += hv * w0; ga[r][1] += hv * w1; } }
                  const float* wj = j == 0 ? p.w_a : (j == 1 ? p.w_b : p.w_m); const int yc = j == 0 ? C_QA : (j == 1 ? C_QB : C_QM);
                  for (int k = 0; k < 512; ++k) { const float w0 = wj[(size_t)k * 1024 + c0], w1 = wj[(size_t)k * 1024 + c0 + 1];
#pragma unroll
                      for (int r = 0; r < 4; ++r) { const float yv = __uint_as_float((unsigned)U[((size_t)pm * 256 + r0 + r) * UP + yc + k] << 16); br[r][0] += yv * w0; br[r][1] += yv * w1; } }
#pragma unroll
                  for (int r = 0; r < 4; ++r) { mg[r][0] += sigmoid_f(ga[r][0] + p.b_merge[j * 1024 + c0]) * br[r][0]; mg[r][1] += sigmoid_f(ga[r][1] + p.b_merge[j * 1024 + c0 + 1]) * br[r][1]; }
              }
              __syncthreads();
#pragma unroll
              for (int r = 0; r < 4; ++r) { mrg[r * 1024 + c0] = mg[r][0]; mrg[r * 1024 + c0 + 1] = mg[r][1]; }
              __syncthreads();
              float ov[4][2];
              for (int r = 0; r < 4; ++r) { ov[r][0] = 0.f; ov[r][1] = 0.f; }
              for (int k = 0; k < 1024; ++k) { const float w0 = p.w_out[(size_t)k * 1024 + c0], w1 = p.w_out[(size_t)k * 1024 + c0 + 1];
#pragma unroll
                  for (int r = 0; r < 4; ++r) { const float mv = mrg[r * 1024 + k]; ov[r][0] += mv * w0; ov[r][1] += mv * w1; } }
#pragma unroll
              for (int r = 0; r < 4; ++r) { float ss = wave_sum(ov[r][0] * ov[r][0] + ov[r][1] * ov[r][1]); if ((t4 & 63) == 0) red[r * 8 + (t4 >> 6)] = ss; }
              __syncthreads();
#pragma unroll
              for (int r = 0; r < 4; ++r) { float ss = 0.f; for (int w = 0; w < 8; ++w) ss += red[r * 8 + w]; const float rstd = rsqrtf(ss * (1.0f / DM) + EPS); const size_t row = (size_t)pm * 256 + r0 + r;
                  p.out[row * DM + c0] = p.x[row * DM + c0] + ov[r][0] * rstd * p.g_post[c0]; p.out[row * DM + c0 + 1] = p.x[row * DM + c0 + 1] + ov[r][1] * rstd * p.g_post[c0 + 1]; }
              __syncthreads();
          }
          continue; }
#endif
#ifdef P3_NAIVE_S2
        {
          int t4 = threadIdx.x; asm volatile("" : "+v"(t4)); const int c0 = 2 * t4;
          for (int r0 = 0; r0 < 256; r0 += 4) {
              float mg[4][2];
              for (int r = 0; r < 4; ++r) { mg[r][0] = 0.f; mg[r][1] = 0.f; }
              for (int j = 0; j < 3; ++j) {
                  float ga[4][2], br[4][2];
                  for (int r = 0; r < 4; ++r) { ga[r][0] = ga[r][1] = br[r][0] = br[r][1] = 0.f; }
                  for (int k = 0; k < 1024; ++k) { const float w0 = p.w_in[(size_t)k * IN_COLS + 8200 + j * 1024 + c0], w1 = p.w_in[(size_t)k * IN_COLS + 8200 + j * 1024 + c0 + 1];
#pragma unroll
                      for (int r = 0; r < 4; ++r) { const float hv = __uint_as_float((unsigned)H[((size_t)pm * 256 + r0 + r) * 1024 + k] << 16); ga[r][0] += hv * w0; ga[r][1] += hv * w1; } }
                  const float* wj = j == 0 ? p.w_a : (j == 1 ? p.w_b : p.w_m); const int yc = j == 0 ? C_QA : (j == 1 ? C_QB : C_QM);
                  for (int k = 0; k < 512; ++k) { const float w0 = wj[(size_t)k * 1024 + c0], w1 = wj[(size_t)k * 1024 + c0 + 1];
#pragma unroll
                      for (int r = 0; r < 4; ++r) { const float yv = __uint_as_float((unsigned)U[((size_t)pm * 256 + r0 + r) * UP + yc + k] << 16); br[r][0] += yv * w0; br[r][1] += yv * w1; } }
#pragma unroll
                  for (int r = 0; r < 4; ++r) { mg[r][0] += sigmoid_f(ga[r][0] + p.b_merge[j * 1024 + c0]) * br[r][0]; mg[r][1] += sigmoid_f(ga[r][1] + p.b_merge[j * 1024 + c0 + 1]) * br[r][1]; }
              }
#pragma unroll
              for (int r = 0; r < 4; ++r) *(unsigned*)(Mg + (size_t)(r0 + r) * UP + c0) = pk_bf16(mg[r][0], mg[r][1]);
          }
          blk_sync_mem(); }
        for (int j = 3; j < 3; ++j) {
#else
        for (int j = 0; j < 3; ++j) {
#endif
#ifdef S2B_NAIVE
            { int t4 = threadIdx.x; asm volatile("" : "+v"(t4)); const int c0 = 2 * t4; const float* wj = j == 0 ? p.w_a : (j == 1 ? p.w_b : p.w_m); const int yc = j == 0 ? C_QA : (j == 1 ? C_QB : C_QM);
              for (int r0 = 0; r0 < 256; r0 += 8) { float br[8][2];
                  for (int r = 0; r < 8; ++r) { br[r][0] = 0.f; br[r][1] = 0.f; }
                  for (int k = 0; k < 512; ++k) { const float w0 = wj[(size_t)k * 1024 + c0], w1 = wj[(size_t)k * 1024 + c0 + 1];
#pragma unroll
                      for (int r = 0; r < 8; ++r) { const float yv = __uint_as_float((unsigned)U[((size_t)pm * 256 + r0 + r) * UP + yc + k] << 16); br[r][0] += yv * w0; br[r][1] += yv * w1; } }
#pragma unroll
                  for (int r = 0; r < 8; ++r) { const unsigned gw = *(const unsigned*)(Gt + (size_t)(r0 + r) * UP + c0); float z0 = br[r][0] * bf_lo(gw), z1 = br[r][1] * bf_hi(gw);
                      if (j > 0) { const unsigned mw = *(const unsigned*)(Mg + (size_t)(r0 + r) * UP + c0); z0 += bf_lo(mw); z1 += bf_hi(mw); }
                      *(unsigned*)(Mg + (size_t)(r0 + r) * UP + c0) = pk_bf16(z0, z1); } } }
#else
#ifndef NO_S2B
            { const bf16_t* Aj = U + (j == 0 ? C_QA : (j == 1 ? C_QB : C_QM)); const bf16_t* Wj = (const bf16_t*)(ws + OFF_WA + (size_t)j * MiB);
              pg8::Gemm g{Aj, Wj, NTOK, 1024, 512, UP}; PanelOrder S{pm, 0, 4}; EpiBr E{Mg, Gall + j * 1024, j == 0 ? 1 : 0, j, TP, UP};
              pg8::gemm_phase<EpiBr, PanelOrder, true, true>(lds, g, S, E); }
#endif
#endif
            blk_sync_mem();
        }
#if defined(DBG_STAGE) && DBG_STAGE == 2
        { int t4 = threadIdx.x; asm volatile("" : "+v"(t4)); const int lane = t4 & 63, wid = t4 >> 6;
          for (int rl = wid; rl < 256; rl += 8) { const size_t row = (size_t)pm * 256 + rl;
              for (int i = 0; i < 4; ++i) { const int k = 4 * lane + 256 * i; const u32x2 w = *(const u32x2*)(Mg + (size_t)rl * UP + k); const f32x4 xv = *(const f32x4*)(p.x + row * DM + k);
                  f32x4 o; o[0] = xv[0] + bf_lo(w.x); o[1] = xv[1] + bf_hi(w.x); o[2] = xv[2] + bf_lo(w.y); o[3] = xv[3] + bf_hi(w.y); *(f32x4*)(p.out + row * DM + k) = o; } }
          continue; }
#endif
#if defined(DBG_STAGE) && DBG_STAGE == 21
        continue;
#endif
#ifndef NO_S3
        { pg8::Gemm g{Mg, (const bf16_t*)(ws + OFF_WOUT), 256, 1024, DM, TP}; PanelOrder S{0, 0, 4}; EpiOut E{U + (size_t)pm * 256 * UP, (LAS3 float*)(lds + 131072), pm * 256};
          pg8::gemm_phase<EpiOut, PanelOrder, true, true>(lds, g, S, E); }
#endif
        blk_sync_mem();
#if defined(DBG_STAGE) && DBG_STAGE == 3
        { int t4 = threadIdx.x; asm volatile("" : "+v"(t4)); const int lane = t4 & 63, wid = t4 >> 6;
          for (int rl = wid; rl < 256; rl += 8) { const size_t row = (size_t)pm * 256 + rl;
              for (int i = 0; i < 4; ++i) { const int k = 4 * lane + 256 * i; const u32x2 w = *(const u32x2*)(U + row * UP + C_OUT + k); const f32x4 xv = *(const f32x4*)(p.x + row * DM + k);
                  f32x4 o; o[0] = xv[0] + bf_lo(w.x); o[1] = xv[1] + bf_hi(w.x); o[2] = xv[2] + bf_lo(w.y); o[3] = xv[3] + bf_hi(w.y); *(f32x4*)(p.out + row * DM + k) = o; } }
          continue; }
#endif
        int t4 = threadIdx.x; asm volatile("" : "+v"(t4));
        const int lane = t4 & 63, wid = t4 >> 6;
        for (int rl = wid; rl < 256; rl += 8) { const size_t row = (size_t)pm * 256 + rl;
            const LAS3 f32x4* sp = (const LAS3 f32x4*)(lds + 131072 + rl * 64); const f32x4 s0 = sp[0], s1 = sp[1], s2 = sp[2], s3 = sp[3];
            const float ssq = (((s0[0] + s0[1]) + (s0[2] + s0[3])) + ((s1[0] + s1[1]) + (s1[2] + s1[3]))) + (((s2[0] + s2[1]) + (s2[2] + s2[3])) + ((s3[0] + s3[1]) + (s3[2] + s3[3])));
            const float rstd = rsqrtf(ssq * (1.0f / DM) + EPS);
#pragma unroll
            for (int i = 0; i < 4; ++i) { const int k = 4 * lane + 256 * i; const u32x2 w = *(const u32x2*)(U + row * UP + C_OUT + k);
                const f32x4 xv = *(const f32x4*)(p.x + row * DM + k), gv = *(const f32x4*)(p.g_post + k);
                f32x4 o; o[0] = xv[0] + bf_lo(w.x) * rstd * gv[0]; o[1] = xv[1] + bf_hi(w.x) * rstd * gv[1]; o[2] = xv[2] + bf_lo(w.y) * rstd * gv[2]; o[3] = xv[3] + bf_hi(w.y) * rstd * gv[3];
                *(f32x4*)(p.out + row * DM + k) = o; } }
#ifdef DBG_GCHK
        { int t6 = threadIdx.x; asm volatile("" : "+v"(t6)); const float cdv = ((const float*)(ws + OFF_ROWSS))[(pm & 127) * 512 + t6]; if (cdv > 1.f) p.out[(size_t)pm * 256 * DM + t6] = cdv; }
#endif
#ifdef DBG_WCHK
        {
          int t4 = threadIdx.x; asm volatile("" : "+v"(t4)); int bad = 0;
          for (int e = pm * 512 + t4; e < 3072 * 1024; e += 256 * 512) { const int n = e >> 10, k = e & 1023;
              const float ref = p.w_in[(size_t)k * IN_COLS + 8200 + n]; const unsigned short want = (unsigned short)(pk_bf16(ref, 0.f) & 0xffffu);
              if (WT[(size_t)(8192 + n) * 1024 + k] != want) bad |= 1; }
          for (int e = pm * 512 + t4; e < 3 * 1024 * 1024; e += 256 * 512) { const int w = e >> 20, n = (e >> 10) & 1023, k = e & 1023;
              const float* src = w == 0 ? p.w_a : (w == 1 ? p.w_b : p.w_m); const float ref = k < 512 ? src[(size_t)k * 1024 + n] : 0.f; const unsigned short want = (unsigned short)(pk_bf16(ref, 0.f) & 0xffffu);
              if (((const bf16_t*)(ws + OFF_WP))[(size_t)w * 1024 * 1024 + (size_t)n * 1024 + k] != want) bad |= 2; }
          if (bad) p.out[(size_t)pm * 256 * DM + t4] = 1e4f * bad; }
#endif
        blk_sync_mem();
    }
}

__global__ void __launch_bounds__(512) mega(Params p, int ph_lo, int ph_hi) {
    extern __shared__ __attribute__((aligned(16))) unsigned char smem[];
    LAS3 unsigned char* lds = (LAS3 unsigned char*)smem;
    cg::grid_group grid = cg::this_grid();
#define MK_IN(k) (ph_lo <= (k) && (k) < ph_hi)
#define GSYNC() do { __builtin_amdgcn_fence(__ATOMIC_RELEASE, "agent"); grid.sync(); __builtin_amdgcn_fence(__ATOMIC_ACQUIRE, "agent"); } while (0)
#ifndef NO_P0
    if (MK_IN(0)) { phase0(p, lds); if (MK_IN(1)) GSYNC(); }
#endif
#ifndef NO_P1
    if (MK_IN(1)) { phase1(p, lds); if (MK_IN(2)) GSYNC(); }
#endif
#ifndef NO_P2
    if (MK_IN(2)) { phase2(p, lds); if (MK_IN(3)) GSYNC(); }
#endif
#ifndef NO_P3
    if (MK_IN(3)) phase3(p, lds);
#endif
}
}

#ifndef MK_N_LAUNCHES
#define MK_N_LAUNCHES 1
#endif
extern "C" void kernel_launch(void* const* d_in, const int* in_sizes, int n_in, void* d_out, int out_size, void* d_ws, size_t ws_size, hipStream_t stream) {
    static int grid = 0;
    if (grid == 0) {
        if (n_in != 14 || in_sizes[0] != mk::NTOK * mk::DM || out_size != mk::NTOK * mk::DM || ws_size < mk::WS_NEED) { fprintf(stderr, "kernel_launch: unexpected shapes / workspace (%zu)\n", ws_size); grid = -1; return; }
        int dev = 0, cus = 0, per_cu = 0;
        hipGetDevice(&dev); hipDeviceGetAttribute(&cus, hipDeviceAttributeMultiprocessorCount, dev);
        hipFuncSetAttribute((const void*)mk::mega, hipFuncAttributeMaxDynamicSharedMemorySize, mk::LDS_BYTES);
        hipOccupancyMaxActiveBlocksPerMultiprocessor(&per_cu, (const void*)mk::mega, 512, mk::LDS_BYTES);
        if (per_cu < 1) per_cu = 1;
        grid = cus * per_cu;
    }
    if (grid < 0) return;
    mk::Params p{};
    p.x = (const float*)d_in[0]; p.mem = (const float*)d_in[1]; p.pos = (const int*)d_in[2]; p.g_pre = (const float*)d_in[3]; p.g_post = (const float*)d_in[4]; p.g_mem = (const float*)d_in[5];
    p.w_in = (const float*)d_in[6]; p.b_forget = (const float*)d_in[7]; p.b_merge = (const float*)d_in[8]; p.w_mem_kv = (const float*)d_in[9]; p.w_a = (const float*)d_in[10]; p.w_b = (const float*)d_in[11];
    p.w_m = (const float*)d_in[12]; p.w_out = (const float*)d_in[13]; p.out = (float*)d_out; p.ws = (unsigned char*)d_ws;
#if MK_N_LAUNCHES == 1
    int lo = 0, hi = 4; void* args[] = {&p, &lo, &hi};
    hipError_t e = hipLaunchCooperativeKernel((const void*)mk::mega, dim3(grid), dim3(512), args, mk::LDS_BYTES, stream);
    if (e != hipSuccess) fprintf(stderr, "cooperative launch failed: %s (grid %d)\n", hipGetErrorString(e), grid);
#else
    for (int ph = 0; ph < 4; ++ph) hipLaunchKernelGGL(mk::mega, dim3(grid), dim3(512), mk::LDS_BYTES, stream, p, ph, ph + 1);
#endif
}
```

```cpp
#include <hip/hip_runtime.h>
#include <hip/hip_cooperative_groups.h>
#include <hip/hip_bf16.h>
#include <cstdio>
#include <cstdint>
#include <cmath>
namespace cg = cooperative_groups;
namespace pg8 {
#define PG8_LAS __attribute__((address_space(3)))
typedef unsigned short bf16_t;
typedef short bf16x8 __attribute__((ext_vector_type(8)));
typedef float f32x4 __attribute__((ext_vector_type(4)));
typedef unsigned u32x4 __attribute__((ext_vector_type(4)));
constexpr int BM = 256, BK = 64, HALF = 128, HTB = HALF * BK * 2  , STAGE_BYTES = 8 * HTB, NXCD = 8, WGM = 4;

__host__ __device__ __forceinline__ int lds_byte(int r, int c) { const int st = (r >> 4) * 2 + (c >> 5), rr = r & 15, cc = c & 31, ob = rr * 64 + cc * 2; return st * 1024 + (ob ^ (((ob >> 9) & 1) << 5)); }
__host__ __device__ __forceinline__ void stage_rc(int b, int& R, int& C) { const int st = b / 1024, sb = b % 1024, swz = sb ^ (((sb >> 9) & 1) << 5); R = (st >> 1) * 16 + swz / 64; C = (st & 1) * 32 + (swz % 64) / 2; }
__host__ __device__ __forceinline__ int perm32(int rho) { const int n = rho >> 4, i = rho & 15; return 8 * (i >> 2) + 4 * n + (i & 3); }

struct Unit { int pm, pn; };
struct Gemm { const bf16_t* A; const bf16_t* Bt; int M, N, K, lda; };

struct StaticOrder {
    int nM, nN, nwg, G, c;
    __host__ __device__ void init(int M, int N, int G_, int c_) { nM = M / BM; nN = N / BM; nwg = nM * nN; G = G_; c = c_; }
    __host__ __device__ bool next(int i, Unit& u) const {
        const long L = (long)i * G + c; if (L >= nwg) return false;
        int wgid = (int)L; { const int q = nwg / NXCD, r = nwg % NXCD, xcd = wgid % NXCD, off = wgid / NXCD; wgid = (xcd < r ? xcd * (q + 1) : r * (q + 1) + (xcd - r) * q) + off; }
        const int nig = WGM * nN, gid = wgid / nig, fm = gid * WGM, gsz = (nM - fm) < WGM ? (nM - fm) : WGM;
        u.pm = fm + ((wgid % nig) % gsz); u.pn = (wgid % nig) / gsz; return true;
    }
    __device__ __forceinline__ void a_ready(const Unit&) const {}
    __device__ __forceinline__ void done(const Unit&) const {}
};

__device__ __forceinline__ unsigned cvt_pk_bf16(float lo, float hi) { unsigned r; asm volatile("v_cvt_pk_bf16_f32 %0, %1, %2" : "=v"(r) : "v"(lo), "v"(hi)); return r; }
typedef float f32x2 __attribute__((ext_vector_type(2)));
template <class Epi, class Sched, bool ALIGN_EPI = false, bool SP2 = false>
__device__ __forceinline__ void gemm_phase(PG8_LAS unsigned char* lds, const Gemm g, const Sched& S, const Epi& E) {
    int tid = threadIdx.x; asm volatile("" : "+v"(tid));
    const int wid = __builtin_amdgcn_readfirstlane(tid >> 6), lane = tid & 63, wr = wid >> 2, wc = wid & 3, fr = lane & 15, fq = lane >> 4;
    const int K = g.K, nt = K / BK;
    unsigned voffA[2], voffB[2];
#pragma unroll
    for (int i = 0; i < 2; ++i) { int R, C; stage_rc(tid * 16 + i * 8192, R, C); const int Rb = Epi::PERM ? ((R & ~31) + perm32(R & 31)) : R;
        voffA[i] = (unsigned)(R * g.lda + C) * 2u; voffB[i] = (unsigned)(Rb * K + C) * 2u; }
    const size_t kstep = (size_t)(BK * 2);
    const size_t hstepA = (size_t)HALF * g.lda * 2, hstepB = (size_t)HALF * K * 2;
    const size_t tstepA = 2 * hstepA, tstepB = 2 * hstepB;
    const unsigned ldsw = (unsigned)wid * 1024u;
    const int aoff = lds_byte(wr * 64 + fr, fq * 8), boff = lds_byte(wc * 32 + fr, fq * 8);
#define PG8_SA(b, h) (((b) * 2 + (h)) * HTB)
#define PG8_SB(b, h) ((4 + (b) * 2 + (h)) * HTB)
#define PG8_STAGE(bufoff, gbase, voff) do { _Pragma("unroll") for (int _i = 0; _i < 2; ++_i) \
        __builtin_amdgcn_global_load_lds((const unsigned*)((const char*)(gbase) + (voff)[_i]), (PG8_LAS unsigned*)(lds + (bufoff) + ldsw + _i * 8192), 16, 0, 0); } while (0)
#define PG8_LDA(dst, b, h) do { _Pragma("unroll") for (int m = 0; m < 4; ++m) _Pragma("unroll") for (int k = 0; k < 2; ++k) dst[m][k] = *(const PG8_LAS bf16x8*)(lds + PG8_SA(b, h) + aoff + m * 2048 + k * 1024); } while (0)
#define PG8_LDB(dst, b, h) do { _Pragma("unroll") for (int n = 0; n < 2; ++n) _Pragma("unroll") for (int k = 0; k < 2; ++k) dst[n][k] = *(const PG8_LAS bf16x8*)(lds + PG8_SB(b, h) + boff + n * 2048 + k * 1024); } while (0)
#define PG8_MMA(ai, bj, At, Bt) do { __builtin_amdgcn_s_setprio(1); _Pragma("unroll") for (int m = 0; m < 4; ++m) _Pragma("unroll") for (int n = 0; n < 2; ++n) _Pragma("unroll") for (int k = 0; k < 2; ++k) \
        acc[ai][bj][m][n] = __builtin_amdgcn_mfma_f32_16x16x32_bf16(Bt[n][k], At[m][k], acc[ai][bj][m][n], 0, 0, 0); __builtin_amdgcn_s_setprio(0); } while (0)
#define PG8_WAIT_V(n) asm volatile("s_waitcnt vmcnt(" #n ")" ::: "memory")
#define PG8_WAIT_L(n) asm volatile("s_waitcnt lgkmcnt(" #n ")" ::: "memory")
#define PG8_BAR __builtin_amdgcn_s_barrier()
#define PG8_SCHED __builtin_amdgcn_sched_barrier(0)
    Unit cur, nxt; int ui = 0;
    if (!S.next(0, cur)) return;
    f32x4 acc[2][2][4][2];
#pragma unroll
    for (int a = 0; a < 2; ++a)
#pragma unroll
        for (int b = 0; b < 2; ++b)
#pragma unroll
            for (int m = 0; m < 4; ++m)
#pragma unroll
                for (int n = 0; n < 2; ++n) acc[a][b][m][n] = (f32x4){0.f, 0.f, 0.f, 0.f};
    bf16x8 At[4][2], B0[2][2], B1[2][2];
    const char* cA = (const char*)g.A + (size_t)cur.pm * tstepA; const char* cB = (const char*)g.Bt + (size_t)cur.pn * tstepB;
    S.a_ready(cur);
    if constexpr (SP2) {
        PG8_STAGE(PG8_SB(0, 0), cB, voffB); PG8_STAGE(PG8_SB(0, 1), cB + hstepB, voffB); PG8_STAGE(PG8_SA(0, 0), cA, voffA); PG8_STAGE(PG8_SA(0, 1), cA + hstepA, voffA);
        if (wr == 1) PG8_BAR;
        PG8_WAIT_V(2); PG8_BAR;
        PG8_STAGE(PG8_SB(1, 0), cB + kstep, voffB); PG8_STAGE(PG8_SA(1, 0), cA + kstep, voffA); PG8_STAGE(PG8_SB(1, 1), cB + hstepB + kstep, voffB);
        PG8_WAIT_V(6); PG8_BAR;
    } else {
        PG8_STAGE(PG8_SB(0, 0), cB, voffB); PG8_STAGE(PG8_SA(0, 0), cA, voffA); PG8_STAGE(PG8_SB(0, 1), cB + hstepB, voffB); PG8_STAGE(PG8_SA(0, 1), cA + hstepA, voffA);
        if (wr == 1) PG8_BAR;
        PG8_WAIT_V(4); PG8_BAR;
        PG8_STAGE(PG8_SB(1, 0), cB + kstep, voffB); PG8_STAGE(PG8_SA(1, 0), cA + kstep, voffA); PG8_STAGE(PG8_SB(1, 1), cB + hstepB + kstep, voffB);
        PG8_WAIT_V(6); PG8_BAR;
    }
    for (;;) {
        const bool has_next = S.next(ui + 1, nxt);
        const char* nA = has_next ? (const char*)g.A + (size_t)nxt.pm * tstepA : cA; const char* nB = has_next ? (const char*)g.Bt + (size_t)nxt.pn * tstepB : cB;
        for (int t = 0; t < nt; t += 2) {
            const bool last = (t == nt - 2);
            const char* a1 = cA + (size_t)(t + 1) * kstep;
            const char* a2 = last ? nA : cA + (size_t)(t + 2) * kstep; const char* b2 = last ? nB : cB + (size_t)(t + 2) * kstep;
            const char* a3 = a2 + kstep; const char* b3 = b2 + kstep;
            if (last && has_next) S.a_ready(nxt);
            if constexpr (SP2) {
            PG8_LDB(B0, 0, 0); PG8_LDB(B1, 0, 1); PG8_SCHED; PG8_LDA(At, 0, 0); PG8_STAGE(PG8_SA(1, 1), a1 + hstepA, voffA);
            PG8_WAIT_V(8); PG8_WAIT_L(0); PG8_BAR; PG8_MMA(0, 0, At, B0); PG8_MMA(0, 1, At, B1); PG8_BAR; PG8_SCHED;
            PG8_LDA(At, 0, 1); PG8_STAGE(PG8_SB(0, 0), b2, voffB); PG8_STAGE(PG8_SB(0, 1), b2 + hstepB, voffB); PG8_STAGE(PG8_SA(0, 0), a2, voffA);
            PG8_WAIT_V(8); PG8_WAIT_L(0); PG8_BAR; PG8_MMA(1, 0, At, B0); PG8_MMA(1, 1, At, B1); PG8_BAR; PG8_SCHED;
            PG8_LDB(B0, 1, 0); PG8_LDB(B1, 1, 1); PG8_SCHED; PG8_LDA(At, 1, 0); PG8_STAGE(PG8_SA(0, 1), a2 + hstepA, voffA);
            PG8_WAIT_V(8); PG8_WAIT_L(0); PG8_BAR; PG8_MMA(0, 0, At, B0); PG8_MMA(0, 1, At, B1); PG8_BAR; PG8_SCHED;
            PG8_LDA(At, 1, 1); PG8_STAGE(PG8_SB(1, 0), b3, voffB); PG8_STAGE(PG8_SB(1, 1), b3 + hstepB, voffB); PG8_STAGE(PG8_SA(1, 0), a3, voffA);
            PG8_WAIT_V(8); PG8_WAIT_L(0); PG8_BAR; PG8_MMA(1, 0, At, B0); PG8_MMA(1, 1, At, B1); PG8_BAR; PG8_SCHED;
            } else {
            PG8_LDB(B0, 0, 0); PG8_SCHED; PG8_LDA(At, 0, 0); PG8_STAGE(PG8_SA(1, 1), a1 + hstepA, voffA);
            PG8_WAIT_L(8); PG8_BAR; PG8_WAIT_L(0); PG8_MMA(0, 0, At, B0); PG8_BAR; PG8_SCHED;
            PG8_LDB(B1, 0, 1); PG8_STAGE(PG8_SB(0, 0), b2, voffB);
            PG8_BAR; PG8_WAIT_L(0); PG8_MMA(0, 1, At, B1); PG8_BAR;
            PG8_LDA(At, 0, 1); PG8_STAGE(PG8_SA(0, 0), a2, voffA);
            PG8_BAR; PG8_WAIT_L(0); PG8_MMA(1, 0, At, B0); PG8_BAR; PG8_SCHED;
            PG8_STAGE(PG8_SB(0, 1), b2 + hstepB, voffB);
            PG8_WAIT_V(6); PG8_BAR; PG8_MMA(1, 1, At, B1); PG8_BAR;
            PG8_LDB(B0, 1, 0); PG8_SCHED; PG8_LDA(At, 1, 0); PG8_STAGE(PG8_SA(0, 1), a2 + hstepA, voffA);
            PG8_WAIT_L(8); PG8_BAR; PG8_WAIT_L(0); PG8_MMA(0, 0, At, B0); PG8_BAR; PG8_SCHED;
            PG8_LDB(B1, 1, 1); PG8_STAGE(PG8_SB(1, 0), b3, voffB);
            PG8_BAR; PG8_WAIT_L(0); PG8_MMA(0, 1, At, B1); PG8_BAR;
            PG8_LDA(At, 1, 1); PG8_STAGE(PG8_SA(1, 0), a3, voffA);
            PG8_BAR; PG8_WAIT_L(0); PG8_MMA(1, 0, At, B0); PG8_BAR; PG8_SCHED;
            PG8_STAGE(PG8_SB(1, 1), b3 + hstepB, voffB);
            PG8_WAIT_V(6); PG8_BAR; PG8_MMA(1, 1, At, B1); PG8_BAR;
            }
        }
        if constexpr (ALIGN_EPI) { if (wr == 0) PG8_BAR; }
        if constexpr (!Epi::AFTER_DRAIN) { E(acc, cur, wr, wc, fr, fq, lane); S.done(cur); }
        if (!has_next) break;
#pragma unroll
        for (int a = 0; a < 2; ++a)
#pragma unroll
            for (int b = 0; b < 2; ++b)
#pragma unroll
                for (int m = 0; m < 4; ++m)
#pragma unroll
                    for (int n = 0; n < 2; ++n) acc[a][b][m][n] = (f32x4){0.f, 0.f, 0.f, 0.f};
        cur = nxt; cA = nA; cB = nB; ++ui;
        if constexpr (ALIGN_EPI) { if (wr == 1) PG8_BAR; }
    }
    PG8_WAIT_V(0);
    if constexpr (!ALIGN_EPI) { if (wr == 0) PG8_BAR; }
    PG8_BAR;
    if constexpr (Epi::AFTER_DRAIN) { E.fused(acc, cur, wr, wc, fr, fq, lds, wid, lane); S.done(cur); }
#undef PG8_SA
#undef PG8_SB
#undef PG8_STAGE
#undef PG8_LDA
#undef PG8_LDB
#undef PG8_MMA
#undef PG8_WAIT_V
#undef PG8_WAIT_L
#undef PG8_BAR
#undef PG8_SCHED
}
}
#define PG8_SP2 true
#include <hip/hip_bf16.h>
#include <cmath>
namespace attn_body {
using bf16=__hip_bfloat16;
using bf16x8=__attribute__((ext_vector_type(8)))short;
using s16x4=__attribute__((ext_vector_type(4)))short;
using f32x16=__attribute__((ext_vector_type(16)))float;
using u32x4=__attribute__((ext_vector_type(4)))unsigned;
using f32x4v=__attribute__((ext_vector_type(4)))float;
constexpr int BATCH=8,NHEAD=8,SEQ=8192,D=64,DM=6656;
constexpr int NW=8,QBLK=32,QB=QBLK*NW,KVBLK=64,NQB=SEQ/QB;
constexpr int ATTN_PITCH=DM, ATTN_UNIT_ROWS=QB;
__device__ __forceinline__ int crow(int r,int hi){return (r&3)+8*(r>>2)+4*hi;}
#define SBAR() __builtin_amdgcn_sched_barrier(0)
__device__ __forceinline__ void cmask(f32x16&p0,f32x16&p1,int jb,int qrel,int hi){
  const float NEG=-INFINITY; int kb=64*jb+4*hi;
  #pragma unroll
  for(int r=0;r<16;++r){int kv=kb+(r&3)+8*(r>>2); if(kv>qrel)p0[r]=NEG; if(kv+32>qrel)p1[r]=NEG;}
}

constexpr int NSLOT=3, SLOTB=8192;
constexpr int LDS_K=0, LDS_V=NSLOT*SLOTB, LDS_WS=2*NSLOT*SLOTB, LDS_OST=LDS_WS+NW*64*4, LDS_CB=LDS_OST+NW*4096, LDS_BYTES=LDS_CB+SEQ*4;
constexpr float C2=0.125f*1.4426950408889634f;
__device__ __forceinline__ void glds16(const void*gsrc,unsigned lds_dst){unsigned keep;
  asm volatile("s_mov_b32 %0, m0\n\ts_mov_b32 m0, %2\n\ts_nop 0\n\tglobal_load_lds_dwordx4 %1, off\n\ts_mov_b32 m0, %0":"=&s"(keep):"v"(gsrc),"s"(lds_dst):"memory");}
__device__ __forceinline__ float max3f(float a,float b,float c){float r;asm("v_max3_f32 %0, %1, %2, %3":"=v"(r):"v"(a),"v"(b),"v"(c));return r;}
__device__ __forceinline__ float max2f(float a,float b){float r;asm("v_max_f32_e32 %0, %1, %2":"=v"(r):"v"(a),"v"(b));return r;}
__device__ __forceinline__ float fadd_s(float a,float b){float r;asm("v_add_f32_e32 %0, %1, %2":"=v"(r):"v"(a),"v"(b));return r;}
__device__ __forceinline__ float fsub_s(float a,float b){float r;asm("v_sub_f32_e32 %0, %1, %2":"=v"(r):"v"(a),"v"(b));return r;}
typedef float f32x2_t __attribute__((ext_vector_type(2))); typedef __bf16 bf16x2_t __attribute__((ext_vector_type(2)));
__device__ __forceinline__ unsigned cvtpk_s(float lo,float hi){f32x2_t v={lo,hi};bf16x2_t b=__builtin_convertvector(v,bf16x2_t);return __builtin_bit_cast(unsigned,b);}
#define WAIT_BAR(N) asm volatile("s_waitcnt vmcnt(" #N ") lgkmcnt(0)\n\ts_barrier":::"memory")

__device__ __forceinline__ void qkt(f32x16&p0,f32x16&p1,const char*Kslot,const bf16x8*qr,const f32x16&negm,int r32,int hi){
  const char*kb=Kslot+hi*1024+r32*16;
  #pragma unroll
  for(int d0=0;d0<4;++d0){
    const bf16x8 b0=*reinterpret_cast<const bf16x8*>(kb+d0*2048);
    const bf16x8 b1=*reinterpret_cast<const bf16x8*>(kb+d0*2048+512);
    if(d0==0){p0=__builtin_amdgcn_mfma_f32_32x32x16_bf16(b0,qr[0],negm,0,0,0);p1=__builtin_amdgcn_mfma_f32_32x32x16_bf16(b1,qr[0],negm,0,0,0);}
    else{p0=__builtin_amdgcn_mfma_f32_32x32x16_bf16(b0,qr[d0],p0,0,0,0);p1=__builtin_amdgcn_mfma_f32_32x32x16_bf16(b1,qr[d0],p1,0,0,0);}}
}
typedef __attribute__((address_space(3))) const char* lds_cptr;
typedef short v4i16_t __attribute__((ext_vector_type(4)));
__device__ __forceinline__ void kload8(bf16x8*kf,lds_cptr kp){
  kf[0]=*(const __attribute__((address_space(3))) bf16x8*)(kp);      kf[1]=*(const __attribute__((address_space(3))) bf16x8*)(kp+512);
  kf[2]=*(const __attribute__((address_space(3))) bf16x8*)(kp+2048); kf[3]=*(const __attribute__((address_space(3))) bf16x8*)(kp+2560);
  kf[4]=*(const __attribute__((address_space(3))) bf16x8*)(kp+4096); kf[5]=*(const __attribute__((address_space(3))) bf16x8*)(kp+4608);
  kf[6]=*(const __attribute__((address_space(3))) bf16x8*)(kp+6144); kf[7]=*(const __attribute__((address_space(3))) bf16x8*)(kp+6656);
}
__device__ __forceinline__ void kload2(bf16x8*kf,lds_cptr kp,int j){ kf[2*j]=*(const __attribute__((address_space(3))) bf16x8*)(kp+j*2048); kf[2*j+1]=*(const __attribute__((address_space(3))) bf16x8*)(kp+j*2048+512); }
__device__ __forceinline__ s16x4 vtr(lds_cptr p){ return __builtin_bit_cast(s16x4,__builtin_amdgcn_ds_read_tr16_b64_v4i16((__attribute__((address_space(3))) v4i16_t*)p)); }
__device__ __forceinline__ float rowmax(const f32x16&p0,const f32x16&p1){
  float a=max3f(p0[0],p0[1],p1[0]),b=max3f(p0[2],p0[3],p1[1]);a=max3f(a,p1[2],p1[3]);
  #pragma unroll
  for(int r=4;r<16;r+=4){a=max3f(a,p0[r],p0[r+1]);b=max3f(b,p0[r+2],p0[r+3]);a=max3f(a,p1[r],p1[r+1]);b=max3f(b,p1[r+2],p1[r+3]);}
  const float m=max2f(a,b);
  auto rr=__builtin_amdgcn_permlane32_swap(__float_as_uint(m),__float_as_uint(m),false,false);
  return max2f(__uint_as_float(rr[0]),__uint_as_float(rr[1]));
}
__device__ __forceinline__ void pv(f32x16*o,int vb,bf16x8 pa0,bf16x8 pa1,bf16x8 pa2,bf16x8 pa3){
  #pragma unroll
  for(int d0=0;d0<2;++d0){s16x4 lo[4],hi[4];
    #pragma unroll
    for(int ks=0;ks<4;++ks){
      asm volatile("ds_read_b64_tr_b16 %0,%1 offset:%c2":"=&v"(lo[ks]):"v"(vb),"i"(d0*4096+ks*1024):"memory");
      asm volatile("ds_read_b64_tr_b16 %0,%1 offset:%c2":"=&v"(hi[ks]):"v"(vb),"i"(d0*4096+ks*1024+512):"memory");}
    asm volatile("s_waitcnt lgkmcnt(0)":::"memory");SBAR();
    #define PK(k) (bf16x8){lo[k][0],lo[k][1],lo[k][2],lo[k][3],hi[k][0],hi[k][1],hi[k][2],hi[k][3]}
    o[d0]=__builtin_amdgcn_mfma_f32_32x32x16_bf16(pa0,PK(0),o[d0],0,0,0);
    o[d0]=__builtin_amdgcn_mfma_f32_32x32x16_bf16(pa1,PK(1),o[d0],0,0,0);
    o[d0]=__builtin_amdgcn_mfma_f32_32x32x16_bf16(pa2,PK(2),o[d0],0,0,0);
    o[d0]=__builtin_amdgcn_mfma_f32_32x32x16_bf16(pa3,PK(3),o[d0],0,0,0);
    #undef PK
  }
}

#ifndef ATTN_STORE16
#define ATTN_STORE16(p,v) (*(u32x4*)(p)=(v))
#endif
template<int THRL> __device__ __forceinline__ void attn_unit(int b,int h,int qb,const bf16*Q,const bf16*__restrict__ K,const bf16*__restrict__ V,bf16*O,const float*__restrict__ CB,const float*__restrict__ NRM,char*shm){
  const int tid=threadIdx.x,lane=tid&63,r32=lane&31,hi=lane>>5; const int wid=__builtin_amdgcn_readfirstlane(tid>>6);
  const long rowbase=(long)b*SEQ; const int q0=qb*QB;
  const bf16*Qw=Q+(rowbase+q0+wid*QBLK)*DM+h*D;
  int ts;
  { const float*cbg0=CB+(long)(b*NHEAD+h)*SEQ; const float*nq=NRM+((b*8+h)*32+qb)*2,*nk=NRM+4096+(b*8+h)*2;
    const float q0s=__uint_as_float(__hip_atomic_load((const unsigned*)nq,__ATOMIC_RELAXED,__HIP_MEMORY_SCOPE_AGENT)),q1s=__uint_as_float(__hip_atomic_load((const unsigned*)nq+1,__ATOMIC_RELAXED,__HIP_MEMORY_SCOPE_AGENT)),k0s=__uint_as_float(__hip_atomic_load((const unsigned*)nk,__ATOMIC_RELAXED,__HIP_MEMORY_SCOPE_AGENT)),k1s=__uint_as_float(__hip_atomic_load((const unsigned*)nk+1,__ATOMIC_RELAXED,__HIP_MEMORY_SCOPE_AGENT));
    const float thr=2.02f*(sqrtf(q0s*k0s)+sqrtf(q1s*k1s))+24.0f; const int ntf=(q0+QB)/KVBLK; const int tc=2*(lane+1);
    bool ok=false; if(tc<=ntf-4) ok=(cbg0[q0]-cbg0[64*tc-1])>=thr;
    ts=2*__builtin_popcountll(__ballot(ok)); ts=__builtin_amdgcn_readfirstlane(ts); }
  const bf16*Kh=K+(rowbase+(long)ts*KVBLK)*DM+h*D,*Vh=V+(rowbase+(long)ts*KVBLK)*DM+h*D;
  const unsigned lds0=(unsigned)(uintptr_t)shm;
  float*wsf=(float*)(shm+LDS_WS)+wid*64;
  const bf16*ksrc=Kh+(long)lane*DM+wid*8;
  const bf16*vsrc=Vh+(long)(16*(wid&3)+(lane>>2))*DM+(wid>>2)*32+(lane&3)*8;
  const unsigned kdst=lds0+LDS_K+wid*1024, vdst=lds0+LDS_V+wid*1024;
  #define DMA_K(t,slot) glds16(ksrc+(long)(t)*KVBLK*DM,(unsigned)__builtin_amdgcn_readfirstlane(kdst+(slot)))
  #define DMA_V(t,slot) glds16(vsrc+(long)(t)*KVBLK*DM,(unsigned)__builtin_amdgcn_readfirstlane(vdst+(slot)))
  const int vb0=(int)(lds0+LDS_V)+((lane>>4)&1)*32+(lane&3)*8+(4*hi+((lane&15)>>2))*64;
  const char*Kbase=shm+LDS_K; bf16x8 kf[8];
  const lds_cptr shm3=(lds_cptr)shm; const lds_cptr kp0=shm3+LDS_K+hi*1024+r32*16; const lds_cptr vp0=shm3+LDS_V+((lane>>4)&1)*32+(lane&3)*8+(4*hi+((lane&15)>>2))*64;
  const int NT=(q0+QB)/KVBLK-ts;
  { const float*cbg=CB+(long)(b*NHEAD+h)*SEQ+ts*KVBLK; __attribute__((address_space(3))) float*cbl=(__attribute__((address_space(3))) float*)((lds_cptr)shm+LDS_CB);
    for(int i=tid*4;i<q0+QB-ts*KVBLK;i+=2048){ const f32x4v v=*reinterpret_cast<const f32x4v*>(cbg+i); *(__attribute__((address_space(3))) f32x4v*)(cbl+i)=v; } }
  const __attribute__((address_space(3))) float*cbw=(const __attribute__((address_space(3))) float*)((lds_cptr)shm+LDS_CB)+4*hi;
  #define BIAS(P0,P1,t) do{ const __attribute__((address_space(3))) float*cp_=cbw+64*(t); _Pragma("unroll") for(int j_=0;j_<4;++j_){ const f32x4v a_=*(const __attribute__((address_space(3))) f32x4v*)(cp_+8*j_); const f32x4v b_=*(const __attribute__((address_space(3))) f32x4v*)(cp_+32+8*j_); \
      P0[4*j_]+=a_[0];P0[4*j_+1]+=a_[1];P0[4*j_+2]+=a_[2];P0[4*j_+3]+=a_[3]; P1[4*j_]+=b_[0];P1[4*j_+1]+=b_[1];P1[4*j_+2]+=b_[2];P1[4*j_+3]+=b_[3]; } }while(0)
  #define BLOAD(P0,P1,t) do{ const __attribute__((address_space(3))) float*cp_=cbw+64*(t); _Pragma("unroll") for(int j_=0;j_<4;++j_){ const f32x4v a_=*(const __attribute__((address_space(3))) f32x4v*)(cp_+8*j_); const f32x4v b_=*(const __attribute__((address_space(3))) f32x4v*)(cp_+32+8*j_); \
      P0[4*j_]=a_[0];P0[4*j_+1]=a_[1];P0[4*j_+2]=a_[2];P0[4*j_+3]=a_[3]; P1[4*j_]=b_[0];P1[4*j_+1]=b_[1];P1[4*j_+2]=b_[2];P1[4*j_+3]=b_[3]; } }while(0)
  #define BSUB(P0,P1) do{ _Pragma("unroll") for(int r_=0;r_<16;++r_){P0[r_]-=mhat;P1[r_]-=mhat;} }while(0)
  DMA_K(0,0);DMA_V(0,0);DMA_K(1,SLOTB);
  bf16x8 qr[4];
  #pragma unroll
  for(int d0=0;d0<4;++d0)qr[d0]=*reinterpret_cast<const bf16x8*>(&Qw[(long)r32*DM+d0*16+hi*8]);
  float mhat=0.f,l_reg=0.f;f32x16 o[2];o[0]=f32x16{};o[1]=f32x16{};f32x16 negm=f32x16{};asm volatile("":"+v"(negm));
  const int qrel=wid*QBLK+r32;
  #define CMASK(P0,P1,t) do{int jb_=(t)-(NT-4); if(jb_>=0)cmask(P0,P1,jb_,qrel,hi);}while(0)
  bool resc=false;
  #define START(P0,P1) do{ const float rm=rowmax(P0,P1); resc=false; \
    { const float dl=rm; mhat=fadd_s(mhat,dl); \
      _Pragma("unroll") for(int r=0;r<16;++r){P0[r]=fsub_s(P0[r],dl);P1[r]=fsub_s(P1[r],dl);} \
      } \
    _Pragma("unroll") for(int r=0;r<16;++r)P0[r]=__builtin_amdgcn_exp2f(P0[r]); }while(0)
  #define RESC() do{ if(resc){ asm volatile("s_waitcnt lgkmcnt(0)":::"memory"); \
      _Pragma("unroll") for(int d_=0;d_<2;++d_) _Pragma("unroll") for(int r=0;r<16;++r)o[d_][r]*=wsf[crow(r,hi)]; } }while(0)
  f32x16 pA0,pA1,pB0,pB1;
  int sl_prev=0,sl_cur=0,sl_next=SLOTB;
  #define ROT() do{sl_prev=sl_cur;sl_cur=sl_next;sl_next=(sl_next==(NSLOT-1)*SLOTB)?0:sl_next+SLOTB;}while(0)
  DMA_K(2,2*SLOTB);
  WAIT_BAR(3);
  qkt(pA0,pA1,Kbase,qr,negm,r32,hi);asm volatile("s_nop 15\n\ts_nop 7":"+v"(pA0),"+v"(pA1));BIAS(pA0,pA1,0);CMASK(pA0,pA1,0);
  START(pA0,pA1);
  _Pragma("unroll") for(int r=0;r<16;++r)pA1[r]=__builtin_amdgcn_exp2f(pA1[r]);
  WAIT_BAR(0);
  DMA_K(3,0);DMA_V(1,SLOTB);
  ROT();
  BLOAD(pB0,pB1,1); BSUB(pB0,pB1);
  kload8(kf,kp0+sl_cur);
  WAIT_BAR(2);
  s16x4 vlo[8],vhi[8]; u32x4 pw0,pw1,pw2,pw3;
  #define PKW(P,B) cvtpk_s(P[B],P[B+1])
  #define PAF(k) __builtin_bit_cast(bf16x8,pw##k)
  #define VFR(i) (bf16x8){vlo[i][0],vlo[i][1],vlo[i][2],vlo[i][3],vhi[i][0],vhi[i][1],vhi[i][2],vhi[i][3]}
  #define PIN(x) asm volatile("":"+v"(x))
  #define MX3(a,b,c) __builtin_fmaxf(__builtin_fmaxf((a),(b)),(c))
  #define GAPA(MF,A0,A1,A2,A3,W0,W1,PW) do{ MF; sacc+=A0; sacc+=A1; sacc+=A2; sacc+=A3; PIN(sacc); W0; W1; PIN(PW); SBAR(); }while(0)
  #define EX(v) __builtin_amdgcn_exp2f(v)
  #define GAPB(MF,X,B) do{ MF; X[B]=EX(X[B]); X[B+1]=EX(X[B+1]); X[B+2]=EX(X[B+2]); X[B+3]=EX(X[B+3]); PIN(X); SBAR(); }while(0)
  #define VRD(i) do{ vlo[i]=vtr(vp_+(((i)>>2)*4096+((i)&3)*1024)); vhi[i]=vtr(vp_+(((i)>>2)*4096+((i)&3)*1024+512)); }while(0)
  #define KRD(G,j) do{ if(G){ kload2(kf,kp0+sl_next,j); SBAR(); } }while(0)
  #define STEP(C0,C1,P0,P1,t,GK,GV,GL) do{ SBAR(); \
    const lds_cptr vp_=vp0+sl_prev; \
    VRD(0); SBAR(); float sacc=(P0[0]+P0[1]); \
    GAPA(C0=__builtin_amdgcn_mfma_f32_32x32x16_bf16(kf[0],qr[0],C0,0,0,0), P0[2],P0[3],P0[4],P0[5],     pw0[0]=PKW(P0,0), pw0[1]=PKW(P0,2), pw0); \
    VRD(4); SBAR(); GAPA(C1=__builtin_amdgcn_mfma_f32_32x32x16_bf16(kf[1],qr[0],C1,0,0,0), P0[6],P0[7],P0[8],P0[9],     pw0[2]=PKW(P0,4), pw0[3]=PKW(P0,6), pw0); \
    VRD(1); SBAR(); GAPA(C0=__builtin_amdgcn_mfma_f32_32x32x16_bf16(kf[2],qr[1],C0,0,0,0),   P0[10],P0[11],P0[12],P0[13], pw1[0]=PKW(P0,8), pw1[1]=PKW(P0,10), pw1); \
    VRD(5); SBAR(); GAPA(C1=__builtin_amdgcn_mfma_f32_32x32x16_bf16(kf[3],qr[1],C1,0,0,0),   P0[14],P0[15],P1[0],P1[1],   pw1[2]=PKW(P0,12),pw1[3]=PKW(P0,14), pw1); \
    VRD(2); SBAR(); GAPA(C0=__builtin_amdgcn_mfma_f32_32x32x16_bf16(kf[4],qr[2],C0,0,0,0),   P1[2],P1[3],P1[4],P1[5],     pw2[0]=PKW(P1,0), pw2[1]=PKW(P1,2), pw2); \
    VRD(6); SBAR(); GAPA(C1=__builtin_amdgcn_mfma_f32_32x32x16_bf16(kf[5],qr[2],C1,0,0,0),   P1[6],P1[7],P1[8],P1[9],     pw2[2]=PKW(P1,4), pw2[3]=PKW(P1,6), pw2); \
    VRD(3); SBAR(); GAPA(C0=__builtin_amdgcn_mfma_f32_32x32x16_bf16(kf[6],qr[3],C0,0,0,0),   P1[10],P1[11],P1[12],P1[13], pw3[0]=PKW(P1,8), pw3[1]=PKW(P1,10), pw3); \
    VRD(7); SBAR(); GAPA(C1=__builtin_amdgcn_mfma_f32_32x32x16_bf16(kf[7],qr[3],C1,0,0,0),   P1[14],P1[15],0.f,0.f,       pw3[2]=PKW(P1,12),pw3[3]=PKW(P1,14), pw3); \
    l_reg+=sacc; \
    if(GK){DMA_K((t)+3,sl_cur);} if(GV){DMA_V((t)+1,sl_next);} \
    CMASK(C0,C1,t); \
    { float a=MX3(C0[0],C0[1],C1[0]),b=MX3(C0[2],C0[3],C1[1]); a=MX3(a,C1[2],C1[3]); \
      _Pragma("unroll") for(int r=4;r<16;r+=4){a=MX3(a,C0[r],C0[r+1]);b=MX3(b,C0[r+2],C0[r+3]);a=MX3(a,C1[r],C1[r+1]);b=MX3(b,C1[r+2],C1[r+3]);} \
      float rm=__builtin_fmaxf(a,b); { auto rr=__builtin_amdgcn_permlane32_swap(__float_as_uint(rm),__float_as_uint(rm),false,false); rm=__builtin_fmaxf(__uint_as_float(rr[0]),__uint_as_float(rr[1])); } \
      resc=false; \
      if(__builtin_expect(__any(rm>(float)THRL),0)){ const float dl=__builtin_fmaxf(rm,0.f); mhat+=dl; \
        _Pragma("unroll") for(int r=0;r<16;++r){C0[r]-=dl;C1[r]-=dl;} \
        const float f=__builtin_amdgcn_exp2f(-dl); l_reg*=f; if(hi==0)wsf[r32]=f; resc=true; } } \
    SBAR(); BLOAD(P0,P1,(t)+1); SBAR(); \
    GAPB(o[0]=__builtin_amdgcn_mfma_f32_32x32x16_bf16(PAF(0),VFR(0),o[0],0,0,0), C0,0); \
    GAPB(o[1]=__builtin_amdgcn_mfma_f32_32x32x16_bf16(PAF(0),VFR(4),o[1],0,0,0), C0,4); \
    KRD(GL,0); GAPB(o[0]=__builtin_amdgcn_mfma_f32_32x32x16_bf16(PAF(1),VFR(1),o[0],0,0,0), C0,8); \
    KRD(GL,1); GAPB(o[1]=__builtin_amdgcn_mfma_f32_32x32x16_bf16(PAF(1),VFR(5),o[1],0,0,0), C0,12); \
    KRD(GL,2); GAPB(o[0]=__builtin_amdgcn_mfma_f32_32x32x16_bf16(PAF(2),VFR(2),o[0],0,0,0), C1,0); \
    KRD(GL,3); GAPB(o[1]=__builtin_amdgcn_mfma_f32_32x32x16_bf16(PAF(2),VFR(6),o[1],0,0,0), C1,4); \
    GAPB(o[0]=__builtin_amdgcn_mfma_f32_32x32x16_bf16(PAF(3),VFR(3),o[0],0,0,0), C1,8); \
    GAPB(o[1]=__builtin_amdgcn_mfma_f32_32x32x16_bf16(PAF(3),VFR(7),o[1],0,0,0), C1,12); \
    BSUB(P0,P1); \
    }while(0)
  int t=1;
  #undef CMASK
  #define CMASK(P0,P1,t) do{}while(0)
  for(;t+5<NT;t+=2){
    STEP(pB0,pB1,pA0,pA1,t,true,true,true);     WAIT_BAR(2); RESC(); ROT();
    STEP(pA0,pA1,pB0,pB1,t+1,true,true,true);   WAIT_BAR(2); RESC(); ROT();
  }
  #undef CMASK
  #define CMASK(P0,P1,t) do{int jb_=(t)-(NT-4); if(jb_>=0)cmask(P0,P1,jb_,qrel,hi);}while(0)
  #define ENDW(tt) do{ if((tt)+3<NT){WAIT_BAR(2);} else if((tt)+2<NT){WAIT_BAR(1);} else {WAIT_BAR(0);} }while(0)
  for(;t+1<NT;t+=2){
    STEP(pB0,pB1,pA0,pA1,t,(t+3<NT),(t+1<NT),(t+1<NT));       ENDW(t);   RESC(); ROT();
    STEP(pA0,pA1,pB0,pB1,t+1,(t+4<NT),(t+2<NT),(t+2<NT));     ENDW(t+1); RESC(); ROT();
  }
  STEP(pB0,pB1,pA0,pA1,NT-1,false,false,false); RESC();
  { float sacc=pB0[0]+pB0[1]; _Pragma("unroll") for(int r=2;r<16;++r)sacc+=pB0[r]; _Pragma("unroll") for(int r=0;r<16;++r)sacc+=pB1[r]; l_reg+=sacc;
    pw0=(u32x4){PKW(pB0,0),PKW(pB0,2),PKW(pB0,4),PKW(pB0,6)};pw1=(u32x4){PKW(pB0,8),PKW(pB0,10),PKW(pB0,12),PKW(pB0,14)};pw2=(u32x4){PKW(pB1,0),PKW(pB1,2),PKW(pB1,4),PKW(pB1,6)};pw3=(u32x4){PKW(pB1,8),PKW(pB1,10),PKW(pB1,12),PKW(pB1,14)};
    SBAR(); pv(o,vb0+sl_cur,PAF(0),PAF(1),PAF(2),PAF(3)); }
  #undef PKW
  #undef PAF
  #undef VFR
  #undef PIN
  #undef MX3
  #undef GAPA
  #undef GAPB
  #undef EX
  #undef VRD
  #undef KRD
  #undef STEP
  #undef ENDW
  {auto rr=__builtin_amdgcn_permlane32_swap(__float_as_uint(l_reg),__float_as_uint(l_reg),false,false);l_reg=__uint_as_float(rr[0])+__uint_as_float(rr[1]);}
  if(hi==0)wsf[32+r32]=l_reg;asm volatile("s_waitcnt lgkmcnt(0)":::"memory");
  float rli[16];
  #pragma unroll
  for(int r=0;r<16;++r)rli[r]=__builtin_amdgcn_rcpf(wsf[32+crow(r,hi)]);
  bf16*Ow=O+(rowbase+q0+wid*QBLK)*DM+h*D;
  { bf16*stg=(bf16*)(shm+LDS_OST)+wid*2048;
    #pragma unroll
    for(int r=0;r<16;++r){const int orow=crow(r,hi);
      #pragma unroll
      for(int d0=0;d0<2;++d0)stg[orow*64+d0*32+r32]=__float2bfloat16(o[d0][r]*rli[r]);}
    asm volatile("s_waitcnt lgkmcnt(0)":::"memory");
    #pragma unroll
    for(int i=0;i<4;++i){const int row=i*8+(lane>>3),ch=lane&7; const u32x4 v=*(const u32x4*)(stg+row*64+ch*8); ATTN_STORE16(Ow+(long)row*DM+ch*8,v);} }
  asm volatile("s_waitcnt lgkmcnt(0)\n\ts_barrier":::"memory");
  #undef DMA_K
  #undef BIAS
  #undef BLOAD
  #undef BSUB
  #undef DMA_V
  #undef CMASK
  #undef START
  #undef RESC
  #undef ROT
}
constexpr int ATTN_LDS_BYTES=LDS_BYTES;
struct AttnTensors { const bf16* Q; const bf16* K; const bf16* V; bf16* O; const float* CB; const float* NRM; };
struct AttnUnit { int bh; int qb; };
struct StaticOrder {
  int g,c;
  __device__ __forceinline__ explicit StaticOrder(int grid,int block):g(grid),c(block){}
  __device__ __forceinline__ bool next(int i,AttnUnit&u)const{
    if(g==256){ if(i>=8)return false; const int cc=c>>3; u.bh=(c&7)*8+i; u.qb=(cc+4*i)&31; return true; }
    const int e=c+i*g; if(e>=2048)return false; u.bh=e&63; u.qb=31-(e>>6); return true; }
  __device__ __forceinline__ void a_ready(const AttnUnit&)const{}
  __device__ __forceinline__ void done(const AttnUnit&)const{}
};
template<class Sched,int THRL=40> __device__ __forceinline__ void attn_phase(char*lds,const AttnTensors&T,const Sched&S){
  AttnUnit u;
  for(int i=0;S.next(i,u);++i){ S.a_ready(u); attn_unit<THRL>(u.bh/NHEAD,u.bh%NHEAD,u.qb,T.Q,T.K,T.V,T.O,T.CB,T.NRM,lds); S.done(u); }
}
#undef SBAR
#undef WAIT_BAR
}
namespace mk {
#define LAS3 __attribute__((address_space(3)))
typedef unsigned short bf16_t;
typedef short bf16x8 __attribute__((ext_vector_type(8)));
typedef float f32x4 __attribute__((ext_vector_type(4)));
typedef unsigned u32x4 __attribute__((ext_vector_type(4)));
typedef unsigned u32x2 __attribute__((ext_vector_type(2)));
constexpr int NB = 8, S = 8192, DM = 1024, NTOK = NB * S, NMEM = 256;
constexpr int IN_COLS = 11272, UP = 6656;
constexpr int C_QA = 0, C_KA = 1536, C_VA = 3072, C_QB = 4608, C_KB = 5120, C_VB = 5632, C_QM = 6144, C_OUT = 512;
constexpr float EPS = 1e-6f, LOG2E = 1.4426950408889634f;
constexpr float SC128 = 0.08838834764831845f * LOG2E;
constexpr float SC64 = 0.125f * LOG2E;
constexpr size_t MiB = 1u << 20;
constexpr size_t OFF_U = 0, OFF_H = 832 * MiB, OFF_WT = 960 * MiB, OFF_WA = 982 * MiB, OFF_WB = 983 * MiB, OFF_WM = 984 * MiB, OFF_WOUT = 985 * MiB,
                 OFF_WMEM = 987 * MiB, OFF_HM = 989 * MiB, OFF_MKV = 993 * MiB, OFF_LOGF = 997 * MiB, OFF_CB2 = 999 * MiB, OFF_LSE = 1001 * MiB, OFF_ROWSS = 1004 * MiB, OFF_WP = 1005 * MiB, WS_NEED = 1011 * MiB;
static_assert((size_t)NTOK * UP * 2 == 832 * MiB, "U size");
constexpr int LDS_BYTES = 147456;

struct Params {
    const float* x; const float* mem; const int* pos; const float* g_pre; const float* g_post; const float* g_mem; const float* w_in; const float* b_forget; const float* b_merge;
    const float* w_mem_kv; const float* w_a; const float* w_b; const float* w_m; const float* w_out; float* out; unsigned char* ws;
};

typedef float f32x2_mk __attribute__((ext_vector_type(2))); typedef __bf16 bf16x2_mk __attribute__((ext_vector_type(2)));
__device__ __forceinline__ unsigned pk_bf16(float lo, float hi) { f32x2_mk v = {lo, hi}; bf16x2_mk b = __builtin_convertvector(v, bf16x2_mk); return __builtin_bit_cast(unsigned, b); }
__device__ __forceinline__ float bf_lo(unsigned w) { return __uint_as_float(w << 16); }
__device__ __forceinline__ float bf_hi(unsigned w) { return __uint_as_float(w & 0xffff0000u); }
__device__ __forceinline__ float wave_sum(float v) {
#pragma unroll
    for (int o = 32; o >= 1; o >>= 1) v += __shfl_xor(v, o);
    return v;
}
__device__ __forceinline__ float silu_f(float v) { return v * __builtin_amdgcn_rcpf(1.0f + __builtin_amdgcn_exp2f(-v * LOG2E)); }
__device__ __forceinline__ float sigmoid_f(float v) { return __builtin_amdgcn_rcpf(1.0f + __builtin_amdgcn_exp2f(-v * LOG2E)); }
__device__ __forceinline__ void blk_sync_mem() {
    asm volatile("s_waitcnt vmcnt(0) lgkmcnt(0)" ::: "memory"); __syncthreads(); asm volatile("buffer_inv sc1" ::: "memory");
}

__device__ __forceinline__ int wt_colmap(int n0) {
    if (n0 < 4608) return n0;
    if (n0 < 6144) return n0 + 512;
    if (n0 < 6656) return n0 - 6144 + 7176;
    if (n0 < 7168) return n0 - 6656 + 4608;
    if (n0 < 7680) return n0 - 7168 + 6664;
    if (n0 < 8192) return n0 - 7680 + 7688;
    return n0 - 8192 + 8200;
}
__device__ __forceinline__ void tr_tile(LAS3 float* tile, const float* src, int lds_, int c0, int k0, bf16_t* dst, int ldd, int n0) {
    int tid = threadIdx.x; asm volatile("" : "+v"(tid));
#pragma unroll
    for (int i = 0; i < 2; ++i) { const int k = (tid >> 4) + 32 * i, n4 = (tid & 15) * 4;
        const f32x4 v = *(const f32x4*)(src + (size_t)(k0 + k) * lds_ + c0 + n4);
        tile[k * 65 + n4] = v[0]; tile[k * 65 + n4 + 1] = v[1]; tile[k * 65 + n4 + 2] = v[2]; tile[k * 65 + n4 + 3] = v[3]; }
    __syncthreads();
    { const int n = tid >> 3, kc = (tid & 7) * 8; u32x4 w;
      w.x = pk_bf16(tile[(kc + 0) * 65 + n], tile[(kc + 1) * 65 + n]); w.y = pk_bf16(tile[(kc + 2) * 65 + n], tile[(kc + 3) * 65 + n]);
      w.z = pk_bf16(tile[(kc + 4) * 65 + n], tile[(kc + 5) * 65 + n]); w.w = pk_bf16(tile[(kc + 6) * 65 + n], tile[(kc + 7) * 65 + n]);
      *(u32x4*)(dst + (size_t)(n0 + n) * ldd + k0 + kc) = w; }
    __syncthreads();
}
__device__ void phase0(const Params& p, LAS3 unsigned char* lds) {
    int tid = threadIdx.x; asm volatile("" : "+v"(tid)); const int lane = tid & 63, wid = tid >> 6, G = gridDim.x; int bid = blockIdx.x; asm volatile("" : "+s"(bid));
    size_t wz = 0; asm volatile("" : "+s"(wz)); unsigned char* ws = p.ws + wz;
    { LAS3 float* tile = (LAS3 float*)lds;
      for (int t = bid; t < 3712; t += G) {
          if (t < 2816) { const int nt = t >> 4, kt = t & 15; tr_tile(tile, p.w_in, IN_COLS, wt_colmap(nt * 64), kt * 64, (bf16_t*)(ws + OFF_WT), 1024, nt * 64); }
          else if (t < 3200) { const int q = t - 2816, w = q >> 7, r = q & 127, nt = r >> 3, kt = r & 7;
              const float* src = w == 0 ? p.w_a : (w == 1 ? p.w_b : p.w_m); tr_tile(tile, src, 1024, nt * 64, kt * 64, (bf16_t*)(ws + OFF_WA + (size_t)w * MiB), 512, nt * 64); }
          else if (t < 3456) { const int q = t - 3200, nt = q >> 4, kt = q & 15; tr_tile(tile, p.w_out, 1024, nt * 64, kt * 64, (bf16_t*)(ws + OFF_WOUT), 1024, nt * 64); }
          else { const int q = t - 3456, nt = q >> 4, kt = q & 15; tr_tile(tile, p.w_mem_kv, 1024, nt * 64, kt * 64, (bf16_t*)(ws + OFF_WMEM), 1024, nt * 64); }
      } }
    if (bid == 0) for (int i = tid; i < 4096 + 128; i += 512) ((unsigned*)(ws + OFF_ROWSS))[i] = 0u;
    __syncthreads();
    LAS3 float* wfb = (LAS3 float*)lds;
    for (int i = tid; i < 2048; i += 512) { const int k = i >> 1, hf = i & 1; const f32x4 v = *(const f32x4*)(p.w_in + (size_t)k * IN_COLS + 6656 + hf * 4); *(LAS3 f32x4*)(wfb + k * 8 + hf * 4) = v; }
    __syncthreads();
    bf16_t* H = (bf16_t*)(ws + OFF_H); float* LOGF = (float*)(ws + OFF_LOGF);
    f32x4 v[4];
    { const int r0 = bid * 8 + wid; if (r0 < NTOK) {
#pragma unroll
        for (int i = 0; i < 4; ++i) v[i] = *(const f32x4*)(p.x + (size_t)r0 * DM + 4 * lane + 256 * i); } }
    for (int row = bid * 8 + wid; row < NTOK; row += G * 8) {
        const int nrow = row + G * 8; f32x4 nv[4];
#pragma unroll
        for (int i = 0; i < 4; ++i) nv[i] = (f32x4){0.f, 0.f, 0.f, 0.f};
        if (nrow < NTOK) {
#pragma unroll
            for (int i = 0; i < 4; ++i) nv[i] = *(const f32x4*)(p.x + (size_t)nrow * DM + 4 * lane + 256 * i); }
        float ss = 0.f;
#pragma unroll
        for (int i = 0; i < 4; ++i) ss += v[i][0] * v[i][0] + v[i][1] * v[i][1] + v[i][2] * v[i][2] + v[i][3] * v[i][3];
        ss = wave_sum(ss); const float rstd = rsqrtf(ss * (1.0f / DM) + EPS);
        float fa[8];
#pragma unroll
        for (int e = 0; e < 8; ++e) fa[e] = 0.f;
#pragma unroll
        for (int i = 0; i < 4; ++i) { const int k = 4 * lane + 256 * i; const f32x4 g = *(const f32x4*)(p.g_pre + k); f32x4 y = v[i] * rstd * g;
            u32x2 w; w.x = pk_bf16(y[0], y[1]); w.y = pk_bf16(y[2], y[3]); *(u32x2*)(H + (size_t)row * DM + k) = w;
#pragma unroll
            for (int j = 0; j < 4; ++j) { const f32x4 w0 = *(const LAS3 f32x4*)(wfb + (k + j) * 8), w1 = *(const LAS3 f32x4*)(wfb + (k + j) * 8 + 4);
                fa[0] += y[j] * w0[0]; fa[1] += y[j] * w0[1]; fa[2] += y[j] * w0[2]; fa[3] += y[j] * w0[3]; fa[4] += y[j] * w1[0]; fa[5] += y[j] * w1[1]; fa[6] += y[j] * w1[2]; fa[7] += y[j] * w1[3]; } }
#pragma unroll
        for (int e = 0; e < 8; ++e) fa[e] = wave_sum(fa[e]);
        float mine = fa[0];
#pragma unroll
        for (int e = 1; e < 8; ++e) mine = (lane == e) ? fa[e] : mine;
        if (lane < 8) { const float z = mine + p.b_forget[lane]; const float lf = -(fmaxf(-z, 0.f) + log1pf(expf(-fabsf(z))));
            const int b = row / S, s = row % S; LOGF[(size_t)(b * 8 + lane) * S + s] = lf; }
#pragma unroll
        for (int i = 0; i < 4; ++i) v[i] = nv[i];
    }
    bf16_t* HM = (bf16_t*)(ws + OFF_HM);
    for (int row = bid * 8 + wid; row < NB * NMEM; row += G * 8) {
        const float* xr = p.mem + (size_t)row * DM; f32x4 v[4]; float ss = 0.f;
#pragma unroll
        for (int i = 0; i < 4; ++i) { v[i] = *(const f32x4*)(xr + 4 * lane + 256 * i); ss += v[i][0] * v[i][0] + v[i][1] * v[i][1] + v[i][2] * v[i][2] + v[i][3] * v[i][3]; }
        ss = wave_sum(ss); const float rstd = rsqrtf(ss * (1.0f / DM) + EPS);
#pragma unroll
        for (int i = 0; i < 4; ++i) { const int k = 4 * lane + 256 * i; const f32x4 g = *(const f32x4*)(p.g_mem + k); f32x4 y = v[i] * rstd * g;
            u32x2 w; w.x = pk_bf16(y[0], y[1]); w.y = pk_bf16(y[2], y[3]); *(u32x2*)(HM + (size_t)row * DM + k) = w; }
    }
    __syncthreads();
}

__device__ void scan_logf(const Params& p, LAS3 unsigned char* lds) {
    int tid = threadIdx.x; asm volatile("" : "+v"(tid)); const int lane = tid & 63, wid = tid >> 6;
    size_t wz = 0; asm volatile("" : "+s"(wz)); unsigned char* ws = p.ws + wz;
    const float* LOGF = (const float*)(ws + OFF_LOGF); float* CB2 = (float*)(ws + OFF_CB2);
    LAS3 float* wt = (LAS3 float*)lds;
    for (int bh = (int)blockIdx.x - 32 + ((int)blockIdx.x < 32 ? (int)gridDim.x : 0); bh < 64; bh += gridDim.x) {
        const float* src = LOGF + (size_t)bh * S + tid * 16; f32x4 v[4];
#pragma unroll
        for (int i = 0; i < 4; ++i) v[i] = *(const f32x4*)(src + 4 * i);
        float run = 0.f;
#pragma unroll
        for (int i = 0; i < 4; ++i)
#pragma unroll
            for (int j = 0; j < 4; ++j) { run += v[i][j]; v[i][j] = run; }
        float inc = run;
#pragma unroll
        for (int o = 1; o < 64; o <<= 1) { const float t = __shfl_up(inc, o); if (lane >= o) inc += t; }
        if (lane == 63) wt[wid] = inc;
        __syncthreads();
        float base = inc - run;
        for (int w = 0; w < wid; ++w) base += wt[w];
        float* dst = CB2 + (size_t)bh * S + tid * 16;
#pragma unroll
        for (int i = 0; i < 4; ++i) { f32x4 o = (v[i] + base) * (-LOG2E); *(f32x4*)(dst + 4 * i) = o; }
        __syncthreads();
    }
}
using pg8::Unit;
struct EpiP1 {
    static constexpr bool PERM = true, AFTER_DRAIN = false;
    bf16_t* O; int ldc; const int* pos; int mode; unsigned* nrm;
    __device__ __forceinline__ void operator()(f32x4 (&acc)[2][2][4][2], const Unit& u, int wr, int wc, int fr, int fq, int lane) const {
        const int row0 = u.pm * 256 + wr * 64 + fr, colb = u.pn * 256 + wc * 32 + 8 * fq;
        float sc = 1.f; bool rope = false;
        if (mode == 0) { if (u.pn < 6 || u.pn >= 24) sc = SC128; else if (u.pn == 18 || u.pn == 19) sc = SC64; rope = (u.pn < 12) && (wc == 0); }
        if (rope) {
            const float sgn = fq < 2 ? -1.f : 1.f; float inv[8];
#pragma unroll
            for (int e = 0; e < 8; ++e) inv[e] = __builtin_amdgcn_exp2f(-(float)(8 * (fq & 1) + e) * (18.931568569324174f / 16.0f)) * 0.15915494309189535f;
#pragma unroll
            for (int ai = 0; ai < 2; ++ai)
#pragma unroll
                for (int m = 0; m < 4; ++m) { const float pp = (float)pos[row0 + ai * 128 + m * 16];
#pragma unroll
                    for (int n = 0; n < 2; ++n)
#pragma unroll
                        for (int j = 0; j < 4; ++j) { const float fr_ = __builtin_amdgcn_fractf(pp * inv[4 * n + j]);
                            const float sn = __builtin_amdgcn_sinf(fr_) * sgn, cs = __builtin_amdgcn_cosf(fr_);
#pragma unroll
                            for (int bj = 0; bj < 2; ++bj) { const float v = acc[ai][bj][m][n][j]; const float pv = __shfl_xor(v, 32); acc[ai][bj][m][n][j] = v * cs + pv * sn; } }
                    __builtin_amdgcn_sched_barrier(0); }
        }
        if (mode == 0 && u.pn >= 18 && u.pn <= 21) {
            const int kind = u.pn >= 20 ? 1 : 0, bb = (u.pm * 256) >> 13;
#pragma unroll
            for (int bj = 0; bj < 2; ++bj) { float mxs = 0.f;
#pragma unroll
                for (int ai = 0; ai < 2; ++ai)
#pragma unroll
                    for (int m = 0; m < 4; ++m) { const f32x4 a0 = acc[ai][bj][m][0], a1 = acc[ai][bj][m][1];
                        float ss = (a0[0] * a0[0] + a0[1] * a0[1]) + (a0[2] * a0[2] + a0[3] * a0[3]) + (a1[0] * a1[0] + a1[1] * a1[1]) + (a1[2] * a1[2] + a1[3] * a1[3]);
                        ss += __shfl_xor(ss, 16); ss += __shfl_xor(ss, 32); mxs = fmaxf(mxs, ss); }
                mxs = fmaxf(mxs, __shfl_xor(mxs, 1)); mxs = fmaxf(mxs, __shfl_xor(mxs, 2)); mxs = fmaxf(mxs, __shfl_xor(mxs, 4)); mxs = fmaxf(mxs, __shfl_xor(mxs, 8));
                const int hd = (u.pn & 1) * 4 + 2 * bj + (wc >> 1);
                if (lane == 0) atomicMax(nrm + (kind ? 4096 + ((bb * 8 + hd) * 2 + (wc & 1)) : (((bb * 8 + hd) * 32 + (u.pm & 31)) * 2 + (wc & 1))), __float_as_uint(mxs * sc * sc)); }
            __builtin_amdgcn_sched_barrier(0);
        }
#pragma unroll
        for (int ai = 0; ai < 2; ++ai)
#pragma unroll
            for (int m = 0; m < 4; ++m) { bf16_t* rowp = O + (size_t)(row0 + ai * 128 + m * 16) * ldc + colb;
#pragma unroll
                for (int bj = 0; bj < 2; ++bj) { const f32x4 v0 = acc[ai][bj][m][0] * sc, v1 = acc[ai][bj][m][1] * sc; u32x4 w;
                    w.x = pk_bf16(v0[0], v0[1]); w.y = pk_bf16(v0[2], v0[3]); w.z = pk_bf16(v1[0], v1[1]); w.w = pk_bf16(v1[2], v1[3]); *(u32x4*)(rowp + bj * 128) = w; } }
    }
};
__device__ __forceinline__ void unpack8(const u32x4 w, float (&f)[8]) { f[0] = bf_lo(w.x); f[1] = bf_hi(w.x); f[2] = bf_lo(w.y); f[3] = bf_hi(w.y); f[4] = bf_lo(w.z); f[5] = bf_hi(w.z); f[6] = bf_lo(w.w); f[7] = bf_hi(w.w); }
__device__ __forceinline__ u32x4 pack8(const float (&f)[8]) { u32x4 w; w.x = pk_bf16(f[0], f[1]); w.y = pk_bf16(f[2], f[3]); w.z = pk_bf16(f[4], f[5]); w.w = pk_bf16(f[6], f[7]); return w; }
struct EpiZ {
    static constexpr bool PERM = true, AFTER_DRAIN = false;
    bf16_t* U; const float* lse; int row_base;
    __device__ __forceinline__ void operator()(f32x4 (&acc)[2][2][4][2], const Unit& u, int wr, int wc, int fr, int fq, int lane) const {
        const int zt = u.pn >> 1;
#pragma unroll
        for (int ai = 0; ai < 2; ++ai)
#pragma unroll
            for (int m = 0; m < 4; ++m) { const unsigned row = ai * 128 + wr * 64 + m * 16 + fr;
#pragma unroll
                for (int bj = 0; bj < 2; ++bj) { const int cbr = (u.pn & 1) * 256 + bj * 128 + wc * 32 + 8 * fq;
                    float w0 = 1.f, w1 = 0.f, w2 = 0.f;
                    if (zt == 0) { const int head = cbr >> 7; const float l0 = lse[row * 12 + head], l1 = lse[row * 12 + 4 + head], l2 = lse[row * 12 + 8 + head];
                        const float mx = fmaxf(l0, fmaxf(l1, l2)); w0 = __builtin_amdgcn_exp2f(l0 - mx); w1 = __builtin_amdgcn_exp2f(l1 - mx); w2 = __builtin_amdgcn_exp2f(l2 - mx);
                        const float rs = __builtin_amdgcn_rcpf(w0 + w1 + w2); w0 *= rs; w1 *= rs; w2 *= rs; }
                    bf16_t* ptr = U + (row * (unsigned)UP + (unsigned)((zt == 0 ? 0 : (zt == 1 ? C_QB : C_QM)) + cbr));
                    { float v[8]; unpack8(*(const u32x4*)ptr, v);
                      if (zt == 0) { float v1[8], v2[8]; unpack8(*(const u32x4*)(ptr + 512), v1); unpack8(*(const u32x4*)(ptr + 1024), v2);
#pragma unroll
                          for (int e = 0; e < 8; ++e) v[e] = w0 * v[e] + w1 * v1[e] + w2 * v2[e]; }
#pragma unroll
                      for (int j = 0; j < 4; ++j) { v[j] *= silu_f(acc[ai][bj][m][0][j]); v[4 + j] *= silu_f(acc[ai][bj][m][1][j]); }
                      *(u32x4*)ptr = pack8(v); }
                    __builtin_amdgcn_sched_barrier(0); } }
    }
};
struct EpiG {
    static constexpr bool PERM = true, AFTER_DRAIN = false;
    bf16_t* Gt; const float* bias; int ld;
    __device__ __forceinline__ void operator()(f32x4 (&acc)[2][2][4][2], const Unit& u, int wr, int wc, int fr, int fq, int lane) const {
#pragma unroll
        for (int bj = 0; bj < 2; ++bj) { const int c8 = u.pn * 256 + bj * 128 + wc * 32 + 8 * fq; const f32x4 b0 = *(const f32x4*)(bias + c8), b1 = *(const f32x4*)(bias + c8 + 4);
#pragma unroll
            for (int ai = 0; ai < 2; ++ai)
#pragma unroll
                for (int m = 0; m < 4; ++m) { const int rl = ai * 128 + wr * 64 + m * 16 + fr; float z[8];
#pragma unroll
                    for (int j = 0; j < 4; ++j) { z[j] = sigmoid_f(acc[ai][bj][m][0][j] + b0[j]); z[4 + j] = sigmoid_f(acc[ai][bj][m][1][j] + b1[j]); }
                    *(u32x4*)(Gt + ((unsigned)rl * (unsigned)ld + (unsigned)c8)) = pack8(z); } }
    }
};
struct EpiBr {
    static constexpr bool PERM = true, AFTER_DRAIN = false;
    bf16_t* Mg; const bf16_t* Gt; int first; int jj; int ld; int ldg;
    __device__ __forceinline__ void operator()(f32x4 (&acc)[2][2][4][2], const Unit& u, int wr, int wc, int fr, int fq, int lane) const {
#pragma unroll
        for (int ai = 0; ai < 2; ++ai)
#pragma unroll
            for (int m = 0; m < 4; ++m) { const int rl = ai * 128 + wr * 64 + m * 16 + fr;
#pragma unroll
                for (int bj = 0; bj < 2; ++bj) { const int c8 = u.pn * 256 + bj * 128 + wc * 32 + 8 * fq; const unsigned off = (unsigned)rl * (unsigned)ld + (unsigned)c8;
                    float g[8], z[8]; unpack8(*(const u32x4*)(Gt + ((unsigned)rl * (unsigned)ldg + (unsigned)c8)), g);
#pragma unroll
                    for (int j = 0; j < 4; ++j) { z[j] = acc[ai][bj][m][0][j] * g[j]; z[4 + j] = acc[ai][bj][m][1][j] * g[4 + j]; }
#ifdef DBG_ZERO_BR
                    if (jj == DBG_ZERO_BR) { for (int j = 0; j < 8; ++j) z[j] = 0.f; }
#endif
                    if (!first) { float o[8]; unpack8(*(const u32x4*)(Mg + off), o);
#pragma unroll
                        for (int j = 0; j < 8; ++j) z[j] += o[j]; }
                    *(u32x4*)(Mg + off) = pack8(z); } }
    }
};
struct EpiOut {
    static constexpr bool PERM = true, AFTER_DRAIN = false;
    bf16_t* U; LAS3 float* ssp; int row_base;
    __device__ __forceinline__ void operator()(f32x4 (&acc)[2][2][4][2], const Unit& u, int wr, int wc, int fr, int fq, int lane) const {
#pragma unroll
        for (int ai = 0; ai < 2; ++ai)
#pragma unroll
            for (int m = 0; m < 4; ++m) { const unsigned row = ai * 128 + wr * 64 + m * 16 + fr; float ss = 0.f;
#pragma unroll
                for (int bj = 0; bj < 2; ++bj) { const int c8 = u.pn * 256 + bj * 128 + wc * 32 + 8 * fq; float z[8];
#pragma unroll
                    for (int j = 0; j < 4; ++j) { z[j] = acc[ai][bj][m][0][j]; z[4 + j] = acc[ai][bj][m][1][j]; }
#pragma unroll
                    for (int j = 0; j < 8; ++j) ss += z[j] * z[j];
                    *(u32x4*)(U + (row * (unsigned)UP + (unsigned)(C_OUT + c8))) = pack8(z); }
                ss += __shfl_xor(ss, 16); ss += __shfl_xor(ss, 32);
                if (fq == 0) ssp[row * 16 + u.pn * 4 + wc] = ss;
                __builtin_amdgcn_sched_barrier(0); }
    }
};
struct EpiZG {
    static constexpr bool PERM = true, AFTER_DRAIN = false;
    EpiZ z; EpiG g;
    __device__ __forceinline__ void operator()(f32x4 (&acc)[2][2][4][2], const Unit& u, int wr, int wc, int fr, int fq, int lane) const {
        if (u.pn < 6) z(acc, u, wr, wc, fr, fq, lane);
        else { Unit u2; u2.pm = u.pm; u2.pn = u.pn - 6; g(acc, u2, wr, wc, fr, fq, lane); }
    }
};
struct PanelOrder {
    int pm_a, n0, cnt;
    __device__ __forceinline__ bool next(int i, Unit& u) const { if (i >= cnt) return false; u.pm = pm_a; u.pn = n0 + i; return true; }
    __device__ __forceinline__ void a_ready(const Unit&) const {}
    __device__ __forceinline__ void done(const Unit&) const {}
};

namespace at128 {
constexpr int KROW = 272, VROW = 288, LDS_K = 0, LDS_V = 256 * KROW, LDS_TOTAL = LDS_V + 256 * VROW;
typedef short v4i16_t __attribute__((ext_vector_type(4)));
struct UArgs { bf16_t* Qp; long q_rs; const bf16_t* Kp; const bf16_t* Vp; long k_rs; int klo; float* lsep; long lse_rs; };
__device__ __forceinline__ void issue_band(const UArgs& a, int tid, u32x4 (&kreg)[8], u32x4 (&vreg)[8]) {
#pragma unroll
    for (int i = 0; i < 8; ++i) { const int c = tid + 512 * i, row = c >> 4, ch = c & 15; kreg[i] = (u32x4){0u, 0u, 0u, 0u}; vreg[i] = (u32x4){0u, 0u, 0u, 0u};
        if (row >= a.klo) { kreg[i] = *(const u32x4*)(a.Kp + (long)row * a.k_rs + ch * 8); vreg[i] = *(const u32x4*)(a.Vp + (long)row * a.k_rs + ch * 8); } }
}
template <bool BAND>
__device__ __forceinline__ void unit(LAS3 unsigned char* lds, const UArgs& cur, u32x4 (&kreg)[8], u32x4 (&vreg)[8], bool has_next, const UArgs& nxt) {
    bf16_t* Qp = cur.Qp; const long q_rs = cur.q_rs; const int klo = cur.klo; float* lsep = cur.lsep; const long lse_rs = cur.lse_rs;
    int tid = threadIdx.x; asm volatile("" : "+v"(tid));
    const int lane = tid & 63, w = __builtin_amdgcn_readfirstlane(tid >> 6), qi = lane & 15, g = lane >> 4;
#pragma unroll
    for (int i = 0; i < 8; ++i) { const int c = tid + 512 * i, row = c >> 4, ch = c & 15;
        *(LAS3 u32x4*)(lds + LDS_K + row * KROW + ch * 16) = kreg[i]; *(LAS3 u32x4*)(lds + LDS_V + row * VROW + ch * 16) = vreg[i]; }
    const int qrow = 16 * w + qi; bf16_t* qptr = Qp + (long)qrow * q_rs;
    bf16x8 qf[4];
#pragma unroll
    for (int s = 0; s < 4; ++s) qf[s] = *(const bf16x8*)(qptr + 32 * s + 8 * g);
    __syncthreads();
    if (has_next) issue_band(nxt, tid, kreg, vreg);
    constexpr int NT = BAND ? 10 : 16; const int jb = BAND ? w : 0;
    f32x4 st[NT];
#pragma unroll
    for (int jt = 0; jt < NT; ++jt) {
        if (BAND && jt == 9) { st[jt] = (f32x4){-1e30f, -1e30f, -1e30f, -1e30f}; continue; }
        const int j = jb + jt; f32x4 a = (f32x4){0.f, 0.f, 0.f, 0.f};
        const LAS3 unsigned char* kp = lds + LDS_K + (16 * j + qi) * KROW + 16 * g;
#pragma unroll
        for (int s = 0; s < 4; ++s) { const bf16x8 kf = *(const LAS3 bf16x8*)(kp + 64 * s); a = __builtin_amdgcn_mfma_f32_16x16x32_bf16(kf, qf[s], a, 0, 0, 0); }
        if (BAND) { const int qidx = 16 * w + qi;
#pragma unroll
            for (int i = 0; i < 4; ++i) { const int ki = 16 * j + 4 * g + i; const bool ok = (ki >= qidx) && (ki <= qidx + 128) && (ki >= klo); a[i] = ok ? a[i] : -1e30f; } }
        st[jt] = a;
    }
    float mx = -1e30f;
#pragma unroll
    for (int jt = 0; jt < NT; ++jt) mx = fmaxf(mx, fmaxf(fmaxf(st[jt][0], st[jt][1]), fmaxf(st[jt][2], st[jt][3])));
    mx = fmaxf(mx, __shfl_xor(mx, 16)); mx = fmaxf(mx, __shfl_xor(mx, 32));
    float sum = 0.f;
#pragma unroll
    for (int jt = 0; jt < NT; ++jt) {
#pragma unroll
        for (int i = 0; i < 4; ++i) { const float e = __builtin_amdgcn_exp2f(st[jt][i] - mx); st[jt][i] = e; sum += e; } }
    sum += __shfl_xor(sum, 16); sum += __shfl_xor(sum, 32);
    f32x4 o[8];
#pragma unroll
    for (int c = 0; c < 8; ++c) o[c] = (f32x4){0.f, 0.f, 0.f, 0.f};
#pragma unroll
    for (int pp = 0; pp < NT / 2; ++pp) {
        int j0 = jb + 2 * pp, j1 = j0 + 1; if (j1 > 15) j1 = 15;
        u32x4 pw; pw.x = pk_bf16(st[2 * pp][0], st[2 * pp][1]); pw.y = pk_bf16(st[2 * pp][2], st[2 * pp][3]); pw.z = pk_bf16(st[2 * pp + 1][0], st[2 * pp + 1][1]); pw.w = pk_bf16(st[2 * pp + 1][2], st[2 * pp + 1][3]);
        const bf16x8 pf = __builtin_bit_cast(bf16x8, pw);
        const int q4 = qi >> 2, p4 = qi & 3;
        const LAS3 unsigned char* v0 = lds + LDS_V + (16 * j0 + 4 * g + q4) * VROW + 8 * p4;
        const LAS3 unsigned char* v1 = lds + LDS_V + (16 * j1 + 4 * g + q4) * VROW + 8 * p4;
#pragma unroll
        for (int c = 0; c < 8; ++c) {
            const v4i16_t lo = __builtin_amdgcn_ds_read_tr16_b64_v4i16((LAS3 v4i16_t*)(v0 + 32 * c));
            const v4i16_t hi = __builtin_amdgcn_ds_read_tr16_b64_v4i16((LAS3 v4i16_t*)(v1 + 32 * c));
            const bf16x8 vf = (bf16x8){lo[0], lo[1], lo[2], lo[3], hi[0], hi[1], hi[2], hi[3]};
            o[c] = __builtin_amdgcn_mfma_f32_16x16x32_bf16(vf, pf, o[c], 0, 0, 0);
        }
    }
    const float rinv = __builtin_amdgcn_rcpf(sum);
#pragma unroll
    for (int c = 0; c < 8; ++c) { const f32x4 v = o[c] * rinv; u32x2 wv; wv.x = pk_bf16(v[0], v[1]); wv.y = pk_bf16(v[2], v[3]); *(u32x2*)(qptr + 16 * c + 4 * g) = wv; }
    if (lsep && g == 0) lsep[(long)qrow * lse_rs] = mx + __builtin_amdgcn_logf(sum);
    __syncthreads();
}

template <bool BAND>
__device__ void unit_naive(bf16_t* Qp, long q_rs, const bf16_t* Kp, const bf16_t* Vp, long k_rs, int klo, float* lsep, long lse_rs) {
    int tid = threadIdx.x; asm volatile("" : "+v"(tid)); const int lane = tid & 63, w = tid >> 6;
    for (int qrow = w; qrow < 128; qrow += 8) {
        bf16_t* qptr = Qp + (long)qrow * q_rs; float lg[4]; int kidx[4]; bool ok[4];
#pragma unroll
        for (int i = 0; i < 4; ++i) { const int n = lane + 64 * i; kidx[i] = BAND ? qrow + n : n; ok[i] = BAND ? (n <= 128 && kidx[i] >= klo) : true;
            float a = 0.f;
            if (ok[i]) { const bf16_t* kp = Kp + (long)kidx[i] * k_rs;
                for (int c = 0; c < 16; ++c) { const u32x4 qa = *(const u32x4*)(qptr + 8 * c), ka = *(const u32x4*)(kp + 8 * c);
                    a += bf_lo(qa.x) * bf_lo(ka.x) + bf_hi(qa.x) * bf_hi(ka.x) + bf_lo(qa.y) * bf_lo(ka.y) + bf_hi(qa.y) * bf_hi(ka.y) + bf_lo(qa.z) * bf_lo(ka.z) + bf_hi(qa.z) * bf_hi(ka.z) + bf_lo(qa.w) * bf_lo(ka.w) + bf_hi(qa.w) * bf_hi(ka.w); } }
            lg[i] = ok[i] ? a : -1e30f; }
        float mx = fmaxf(fmaxf(lg[0], lg[1]), fmaxf(lg[2], lg[3]));
#pragma unroll
        for (int of = 32; of >= 1; of >>= 1) mx = fmaxf(mx, __shfl_xor(mx, of));
        float sum = 0.f;
#pragma unroll
        for (int i = 0; i < 4; ++i) { lg[i] = ok[i] ? __builtin_amdgcn_exp2f(lg[i] - mx) : 0.f; sum += lg[i]; }
        sum = wave_sum(sum);
        float o0 = 0.f, o1 = 0.f; const int nk = BAND ? 129 : 256;
        for (int n = 0; n < nk; ++n) { const int i = n >> 6; const float pv = __shfl(i == 0 ? lg[0] : (i == 1 ? lg[1] : (i == 2 ? lg[2] : lg[3])), n & 63);
            const int ki = BAND ? qrow + n : n; if (BAND && ki < klo) continue;
            const unsigned vv = *(const unsigned*)(Vp + (long)ki * k_rs + 2 * lane); o0 += pv * bf_lo(vv); o1 += pv * bf_hi(vv); }
        const float ri = 1.0f / sum;
        *(unsigned*)(qptr + 2 * lane) = pk_bf16(o0 * ri, o1 * ri);
        if (lsep && lane == 0) lsep[(long)qrow * lse_rs] = mx + __builtin_amdgcn_logf(sum);
    }
}
}

__device__ void fox_naive(bf16_t* U, const float* CB2) {
    int tid = threadIdx.x; asm volatile("" : "+v"(tid)); const int lane = tid & 63, wid = tid >> 6;
    for (long qi = (long)blockIdx.x * 8 + wid; qi < (long)NTOK * 8; qi += (long)gridDim.x * 8) {
        const int h = (int)(qi & 7); const long row = qi >> 3; const int b = (int)(row / S), t = (int)(row % S);
        const bf16_t* qp = U + row * UP + C_QB + h * 64; const float* cb = CB2 + (size_t)(b * 8 + h) * S;
        float q[64];
#pragma unroll
        for (int c = 0; c < 8; ++c) { const u32x4 w = *(const u32x4*)(qp + 8 * c); q[8*c] = bf_lo(w.x); q[8*c+1] = bf_hi(w.x); q[8*c+2] = bf_lo(w.y); q[8*c+3] = bf_hi(w.y); q[8*c+4] = bf_lo(w.z); q[8*c+5] = bf_hi(w.z); q[8*c+6] = bf_lo(w.w); q[8*c+7] = bf_hi(w.w); }
        float m = -1e30f, l = 0.f; float o[64];
#pragma unroll
        for (int d = 0; d < 64; ++d) o[d] = 0.f;
        for (int s0 = lane; s0 <= t; s0 += 64) {
            const bf16_t* kp = U + ((long)b * S + s0) * UP + C_KB + h * 64; const bf16_t* vp = U + ((long)b * S + s0) * UP + C_VB + h * 64;
            float x = 0.f;
#pragma unroll
            for (int c = 0; c < 8; ++c) { const u32x4 w = *(const u32x4*)(kp + 8 * c);
                x += q[8*c] * bf_lo(w.x) + q[8*c+1] * bf_hi(w.x) + q[8*c+2] * bf_lo(w.y) + q[8*c+3] * bf_hi(w.y) + q[8*c+4] * bf_lo(w.z) + q[8*c+5] * bf_hi(w.z) + q[8*c+6] * bf_lo(w.w) + q[8*c+7] * bf_hi(w.w); }
            x += cb[s0];
            const float mn = fmaxf(m, x), f = __builtin_amdgcn_exp2f(m - mn), pz = __builtin_amdgcn_exp2f(x - mn); m = mn; l = l * f + pz;
#pragma unroll
            for (int c = 0; c < 8; ++c) { const u32x4 w = *(const u32x4*)(vp + 8 * c);
                o[8*c] = o[8*c] * f + pz * bf_lo(w.x); o[8*c+1] = o[8*c+1] * f + pz * bf_hi(w.x); o[8*c+2] = o[8*c+2] * f + pz * bf_lo(w.y); o[8*c+3] = o[8*c+3] * f + pz * bf_hi(w.y);
                o[8*c+4] = o[8*c+4] * f + pz * bf_lo(w.z); o[8*c+5] = o[8*c+5] * f + pz * bf_hi(w.z); o[8*c+6] = o[8*c+6] * f + pz * bf_lo(w.w); o[8*c+7] = o[8*c+7] * f + pz * bf_hi(w.w); }
        }
        float mg = m;
#pragma unroll
        for (int of = 32; of >= 1; of >>= 1) mg = fmaxf(mg, __shfl_xor(mg, of));
        const float sc = __builtin_amdgcn_exp2f(m - mg); l = wave_sum(l * sc); const float rl = 1.0f / l;
        float mine0 = 0.f;
#pragma unroll
        for (int d = 0; d < 64; ++d) { const float v = wave_sum(o[d] * sc) * rl; mine0 = (lane == d) ? v : mine0; }
        const float nb = __shfl_xor(mine0, 1);
        if ((lane & 1) == 0) *(unsigned*)((bf16_t*)qp + lane) = pk_bf16(mine0, nb);
    }
}
__device__ void phase1(const Params& p, LAS3 unsigned char* lds) {
    size_t wz = 0; asm volatile("" : "+s"(wz)); unsigned char* ws = p.ws + wz;
    scan_logf(p, lds);
    { pg8::Gemm g{(const bf16_t*)(ws + OFF_H), (const bf16_t*)(ws + OFF_WT), NTOK, UP, DM, DM}; pg8::StaticOrder S; S.init(NTOK, UP, (int)gridDim.x, (int)blockIdx.x);
      EpiP1 E{(bf16_t*)(ws + OFF_U), UP, p.pos, 0, (unsigned*)(ws + OFF_ROWSS)};
      pg8::gemm_phase<EpiP1, pg8::StaticOrder, true, true>(lds, g, S, E); }
#ifdef MKV_NAIVE
    { int tid = threadIdx.x; asm volatile("" : "+v"(tid)); const bf16_t* HM = (const bf16_t*)(ws + OFF_HM); bf16_t* MKV = (bf16_t*)(ws + OFF_MKV);
      for (int e = blockIdx.x * 512 + tid; e < NB * NMEM * 1024; e += gridDim.x * 512) { const int row = e >> 10, col = e & 1023; float a = 0.f;
          for (int k = 0; k < 1024; ++k) a += __uint_as_float((unsigned)HM[(size_t)row * 1024 + k] << 16) * p.w_mem_kv[(size_t)k * 1024 + col];
          MKV[e] = (bf16_t)(pk_bf16(a, 0.f) & 0xffffu); } }
#else
    { pg8::Gemm g{(const bf16_t*)(ws + OFF_HM), (const bf16_t*)(ws + OFF_WMEM), NB * NMEM, 1024, DM, DM}; pg8::StaticOrder S; S.init(NB * NMEM, 1024, (int)gridDim.x, (int)blockIdx.x);
      EpiP1 E{(bf16_t*)(ws + OFF_MKV), 1024, p.pos, 1, (unsigned*)(ws + OFF_ROWSS)};
      pg8::gemm_phase<EpiP1, pg8::StaticOrder, true, true>(lds, g, S, E); }
#endif
}
#ifdef A_NAIVE
#define AT_UNIT_A(...) at128::unit_naive<true>(__VA_ARGS__)
#else
#define AT_UNIT_A(...) at128::unit<true>(lds, __VA_ARGS__)
#endif
#ifdef M_NAIVE
#define AT_UNIT_M(...) at128::unit_naive<false>(__VA_ARGS__)
#else
#define AT_UNIT_M(...) at128::unit<false>(lds, __VA_ARGS__)
#endif
__device__ void phase2(const Params& p, LAS3 unsigned char* lds) {
    size_t wz = 0; asm volatile("" : "+s"(wz)); unsigned char* ws = p.ws + wz;   bf16_t* U = (bf16_t*)(ws + OFF_U);
#ifdef FOX_NAIVE
    fox_naive(U, (const float*)(ws + OFF_CB2));
#elif !defined(NO_FOX)
    { const attn_body::AttnTensors AT{(const attn_body::bf16*)(U + C_QB), (const attn_body::bf16*)(U + C_KB), (const attn_body::bf16*)(U + C_VB), (attn_body::bf16*)(U + C_QB), (const float*)(ws + OFF_CB2), (const float*)(ws + OFF_ROWSS)};
      const attn_body::StaticOrder SO((int)gridDim.x, (int)blockIdx.x);
      attn_body::attn_phase<attn_body::StaticOrder>((char*)lds, AT, SO); }
#endif
    __syncthreads();
#ifndef NO_AT128
    float* LSE = (float*)(ws + OFF_LSE);
    {
      auto decA = [&](int a0) { const int a = (a0 & 7) * 768 + (a0 >> 3);     const int b = a / 768, rem = a % 768, hh = rem >> 6, blk = rem & 63, grp = hh >> 2, dil = 1 << (2 * grp), nb = 64 >> (2 * grp), r = blk / nb, n = blk % nb;
          const long qrow0 = (long)b * S + (long)(128 * n) * dil + r, krow0 = qrow0 - 128L * dil;
          return at128::UArgs{U + qrow0 * UP + C_QA + hh * 128, (long)dil * UP, U + krow0 * UP + C_KA + hh * 128, U + krow0 * UP + C_VA + hh * 128, (long)dil * UP, n == 0 ? 128 : 0, LSE + qrow0 * 12 + hh, (long)dil * 12}; };
      u32x4 kreg[8], vreg[8]; int tid0 = threadIdx.x; asm volatile("" : "+v"(tid0)); int a = blockIdx.x;
      if (a < 6144) { at128::UArgs cur = decA(a); at128::issue_band(cur, tid0, kreg, vreg);
          for (; a < 6144; a += gridDim.x) { const int an = a + gridDim.x; const bool has = an < 6144; const at128::UArgs nxt = decA(has ? an : a);
              at128::unit<true>(lds, cur, kreg, vreg, has, nxt); cur = nxt; } } }
    const bf16_t* MKV = (const bf16_t*)(ws + OFF_MKV);
    { auto decM = [&](int a0) { const int a = (a0 & 7) * 256 + (a0 >> 3);     const int b = a >> 8, rem = a & 255, h = rem >> 6, n = rem & 63; const long qrow0 = (long)b * S + 128 * n;
          return at128::UArgs{U + qrow0 * UP + C_QM + h * 128, (long)UP, MKV + (long)b * NMEM * 1024 + h * 128, MKV + (long)b * NMEM * 1024 + 512 + h * 128, 1024L, 0, nullptr, 0}; };
      u32x4 kreg[8], vreg[8]; int tid0 = threadIdx.x; asm volatile("" : "+v"(tid0)); int a = blockIdx.x;
      if (a < 2048) { at128::UArgs cur = decM(a); at128::issue_band(cur, tid0, kreg, vreg);
          for (; a < 2048; a += gridDim.x) { const int an = a + gridDim.x; const bool has = an < 2048; const at128::UArgs nxt = decM(has ? an : a);
              at128::unit<false>(lds, cur, kreg, vreg, has, nxt); cur = nxt; } } }
#endif
}
__device__ void phase3(const Params& p, LAS3 unsigned char* lds) {
    size_t wz = 0; asm volatile("" : "+s"(wz)); unsigned char* ws = p.ws + wz;   bf16_t* U = (bf16_t*)(ws + OFF_U); const bf16_t* H = (const bf16_t*)(ws + OFF_H); const bf16_t* WT = (const bf16_t*)(ws + OFF_WT);
    for (int pm = blockIdx.x; pm < NTOK / 256; pm += gridDim.x) {
        bf16_t* Mg = (bf16_t*)((unsigned char*)p.out + (size_t)pm * MiB); bf16_t* Gt = Mg + 256 * 1024; constexpr int TP = 1024;
#ifdef DBG_GT0
        Gt = U + (size_t)pm * 256 * UP;
#endif
        bf16_t* Gall = U + (size_t)pm * 256 * UP + C_KA;
        { pg8::Gemm g{H, WT + (size_t)6656 * 1024, NTOK, 4608, DM, DM}; PanelOrder S{pm, 0, 18};
          EpiZG E{EpiZ{U + (size_t)pm * 256 * UP, (const float*)(ws + OFF_LSE) + (size_t)pm * 256 * 12, pm * 256}, EpiG{Gall, p.b_merge, UP}};
          pg8::gemm_phase<EpiZG, PanelOrder, true, true>(lds, g, S, E); }
        blk_sync_mem();
#if defined(DBG_STAGE) && DBG_STAGE == 1
        { int t4 = threadIdx.x; const int lane = t4 & 63, wid = t4 >> 6;
          for (int rl = wid; rl < 256; rl += 8) { const size_t row = (size_t)pm * 256 + rl;
              for (int i = 0; i < 4; ++i) { const int k = 4 * lane + 256 * i; const u32x2 w = *(const u32x2*)(U + row * UP + DBG_COL + k); const f32x4 xv = *(const f32x4*)(p.x + row * DM + k);
                  f32x4 o; o[0] = xv[0] + bf_lo(w.x); o[1] = xv[1] + bf_hi(w.x); o[2] = xv[2] + bf_lo(w.y); o[3] = xv[3] + bf_hi(w.y); *(f32x4*)(p.out + row * DM + k) = o; } }
          continue; }
#endif
#ifdef P3_NAIVE
        {
          int t4 = threadIdx.x; asm volatile("" : "+v"(t4)); const int c0 = 2 * t4; LAS3 float* mrg = (LAS3 float*)lds; LAS3 float* red = mrg + 4 * 1024;
          for (int r0 = 0; r0 < 256; r0 += 4) {
              float mg[4][2];
              for (int r = 0; r < 4; ++r) { mg[r][0] = 0.f; mg[r][1] = 0.f; }
              for (int j = 0; j < 3; ++j) {
                  float ga[4][2], br[4][2];
                  for (int r = 0; r < 4; ++r) { ga[r][0] = ga[r][1] = br[r][0] = br[r][1] = 0.f; }
                  for (int k = 0; k < 1024; ++k) { const float w0 = p.w_in[(size_t)k * IN_COLS + 8200 + j * 1024 + c0], w1 = p.w_in[(size_t)k * IN_COLS + 8200 + j * 1024 + c0 + 1];
#pragma unroll
                      for (int r = 0; r < 4; ++r) { const float hv = __uint_as_float((unsigned)H[((size_t)pm * 256 + r0 + r) * 1024 + k] << 16); ga[r][0] += hv * w0; ga[r][1] += hv * w1; } }
                  const float* wj = j == 0 ? p.w_a : (j == 1 ? p.w_b : p.w_m); const int yc = j == 0 ? C_QA : (j == 1 ? C_QB : C_QM);
                  for (int k = 0; k < 512; ++k) { const float w0 = wj[(size_t)k * 1024 + c0], w1 = wj[(size_t)k * 1024 + c0 + 1];
#pragma unroll
                      for (int r = 0; r < 4; ++r) { const float yv = __uint_as_float((unsigned)U[((size_t)pm * 256 + r0 + r) * UP + yc + k] << 16); br[r][0] += yv * w0; br[r][1] += yv * w1; } }
#pragma unroll
                  for (int r = 0; r < 4; ++r) { mg[r][0] += sigmoid_f(ga[r][0] + p.b_merge[j * 1024 + c0]) * br[r][0]; mg[r][1] += sigmoid_f(ga[r][1] + p.b_merge[j * 1024 + c0 + 1]) * br[r][1]; }
              }
              __syncthreads();
#pragma unroll
              for (int r = 0; r < 4; ++r) { mrg[r * 1024 + c0] = mg[r][0]; mrg[r * 1024 + c0 + 1] = mg[r][1]; }
              __syncthreads();
              float ov[4][2];
              for (int r = 0; r < 4; ++r) { ov[r][0] = 0.f; ov[r][1] = 0.f; }
              for (int k = 0; k < 1024; ++k) { const float w0 = p.w_out[(size_t)k * 1024 + c0], w1 = p.w_out[(size_t)k * 1024 + c0 + 1];
#pragma unroll
                  for (int r = 0; r < 4; ++r) { const float mv = mrg[r * 1024 + k]; ov[r][0] += mv * w0; ov[r][1] += mv * w1; } }
#pragma unroll
              for (int r = 0; r < 4; ++r) { float ss = wave_sum(ov[r][0] * ov[r][0] + ov[r][1] * ov[r][1]); if ((t4 & 63) == 0) red[r * 8 + (t4 >> 6)] = ss; }
              __syncthreads();
#pragma unroll
              for (int r = 0; r < 4; ++r) { float ss = 0.f; for (int w = 0; w < 8; ++w) ss += red[r * 8 + w]; const float rstd = rsqrtf(ss * (1.0f / DM) + EPS); const size_t row = (size_t)pm * 256 + r0 + r;
                  p.out[row * DM + c0] = p.x[row * DM + c0] + ov[r][0] * rstd * p.g_post[c0]; p.out[row * DM + c0 + 1] = p.x[row * DM + c0 + 1] + ov[r][1] * rstd * p.g_post[c0 + 1]; }
              __syncthreads();
          }
          continue; }
#endif
#ifdef P3_NAIVE_S2
        {
          int t4 = threadIdx.x; asm volatile("" : "+v"(t4)); const int c0 = 2 * t4;
          for (int r0 = 0; r0 < 256; r0 += 4) {
              float mg[4][2];
              for (int r = 0; r < 4; ++r) { mg[r][0] = 0.f; mg[r][1] = 0.f; }
              for (int j = 0; j < 3; ++j) {
                  float ga[4][2], br[4][2];
                  for (int r = 0; r < 4; ++r) { ga[r][0] = ga[r][1] = br[r][0] = br[r][1] = 0.f; }
                  for (int k = 0; k < 1024; ++k) { const float w0 = p.w_in[(size_t)k * IN_COLS + 8200 + j * 1024 + c0], w1 = p.w_in[(size_t)k * IN_COLS + 8200 + j * 1024 + c0 + 1];
#pragma unroll
                      for (int r = 0; r < 4; ++r) { const float hv = __uint_as_float((unsigned)H[((size_t)pm * 256 + r0 + r) * 1024 + k] << 16); ga[r][0] += hv * w0; ga[r][1] += hv * w1; } }
                  const float* wj = j == 0 ? p.w_a : (j == 1 ? p.w_b : p.w_m); const int yc = j == 0 ? C_QA : (j == 1 ? C_QB : C_QM);
                  for (int k = 0; k < 512; ++k) { const float w0 = wj[(size_t)k * 1024 + c0], w1 = wj[(size_t)k * 1024 + c0 + 1];
#pragma unroll
                      for (int r = 0; r < 4; ++r) { const float yv = __uint_as_float((unsigned)U[((size_t)pm * 256 + r0 + r) * UP + yc + k] << 16); br[r][0] += yv * w0; br[r][1] += yv * w1; } }
#pragma unroll
                  for (int r = 0; r < 4; ++r) { mg[r][0] += sigmoid_f(ga[r][0] + p.b_merge[j * 1024 + c0]) * br[r][0]; mg[r][1] += sigmoid_f(ga[r][1] + p.b_merge[j * 1024 + c0 + 1]) * br[r][1]; }
              }
#pragma unroll
              for (int r = 0; r < 4; ++r) *(unsigned*)(Mg + (size_t)(r0 + r) * UP + c0) = pk_bf16(mg[r][0], mg[r][1]);
          }
          blk_sync_mem(); }
        for (int j = 3; j < 3; ++j) {
#else
        for (int j = 0; j < 3; ++j) {
#endif
#ifdef S2B_NAIVE
            { int t4 = threadIdx.x; asm volatile("" : "+v"(t4)); const int c0 = 2 * t4; const float* wj = j == 0 ? p.w_a : (j == 1 ? p.w_b : p.w_m); const int yc = j == 0 ? C_QA : (j == 1 ? C_QB : C_QM);
              for (int r0 = 0; r0 < 256; r0 += 8) { float br[8][2];
                  for (int r = 0; r < 8; ++r) { br[r][0] = 0.f; br[r][1] = 0.f; }
                  for (int k = 0; k < 512; ++k) { const float w0 = wj[(size_t)k * 1024 + c0], w1 = wj[(size_t)k * 1024 + c0 + 1];
#pragma unroll
                      for (int r = 0; r < 8; ++r) { const float yv = __uint_as_float((unsigned)U[((size_t)pm * 256 + r0 + r) * UP + yc + k] << 16); br[r][0] += yv * w0; br[r][1] += yv * w1; } }
#pragma unroll
                  for (int r = 0; r < 8; ++r) { const unsigned gw = *(const unsigned*)(Gt + (size_t)(r0 + r) * UP + c0); float z0 = br[r][0] * bf_lo(gw), z1 = br[r][1] * bf_hi(gw);
                      if (j > 0) { const unsigned mw = *(const unsigned*)(Mg + (size_t)(r0 + r) * UP + c0); z0 += bf_lo(mw); z1 += bf_hi(mw); }
                      *(unsigned*)(Mg + (size_t)(r0 + r) * UP + c0) = pk_bf16(z0, z1); } } }
#else
#ifndef NO_S2B
            { const bf16_t* Aj = U + (j == 0 ? C_QA : (j == 1 ? C_QB : C_QM)); const bf16_t* Wj = (const bf16_t*)(ws + OFF_WA + (size_t)j * MiB);
              pg8::Gemm g{Aj, Wj, NTOK, 1024, 512, UP}; PanelOrder S{pm, 0, 4}; EpiBr E{Mg, Gall + j * 1024, j == 0 ? 1 : 0, j, TP, UP};
              pg8::gemm_phase<EpiBr, PanelOrder, true, true>(lds, g, S, E); }
#endif
#endif
            blk_sync_mem();
        }
#if defined(DBG_STAGE) && DBG_STAGE == 2
        { int t4 = threadIdx.x; asm volatile("" : "+v"(t4)); const int lane = t4 & 63, wid = t4 >> 6;
          for (int rl = wid; rl < 256; rl += 8) { const size_t row = (size_t)pm * 256 + rl;
              for (int i = 0; i < 4; ++i) { const int k = 4 * lane + 256 * i; const u32x2 w = *(const u32x2*)(Mg + (size_t)rl * UP + k); const f32x4 xv = *(const f32x4*)(p.x + row * DM + k);
                  f32x4 o; o[0] = xv[0] + bf_lo(w.x); o[1] = xv[1] + bf_hi(w.x); o[2] = xv[2] + bf_lo(w.y); o[3] = xv[3] + bf_hi(w.y); *(f32x4*)(p.out + row * DM + k) = o; } }
          continue; }
#endif
#if defined(DBG_STAGE) && DBG_STAGE == 21
        continue;
#endif
#ifndef NO_S3
        { pg8::Gemm g{Mg, (const bf16_t*)(ws + OFF_WOUT), 256, 1024, DM, TP}; PanelOrder S{0, 0, 4}; EpiOut E{U + (size_t)pm * 256 * UP, (LAS3 float*)(lds + 131072), pm * 256};
          pg8::gemm_phase<EpiOut, PanelOrder, true, true>(lds, g, S, E); }
#endif
        blk_sync_mem();
#if defined(DBG_STAGE) && DBG_STAGE == 3
        { int t4 = threadIdx.x; asm volatile("" : "+v"(t4)); const int lane = t4 & 63, wid = t4 >> 6;
          for (int rl = wid; rl < 256; rl += 8) { const size_t row = (size_t)pm * 256 + rl;
              for (int i = 0; i < 4; ++i) { const int k = 4 * lane + 256 * i; const u32x2 w = *(const u32x2*)(U + row * UP + C_OUT + k); const f32x4 xv = *(const f32x4*)(p.x + row * DM + k);
                  f32x4 o; o[0] = xv[0] + bf_lo(w.x); o[1] = xv[1] + bf_hi(w.x); o[2] = xv[2] + bf_lo(w.y); o[3] = xv[3] + bf_hi(w.y); *(f32x4*)(p.out + row * DM + k) = o; } }
          continue; }
#endif
        int t4 = threadIdx.x; asm volatile("" : "+v"(t4));
        const int lane = t4 & 63, wid = t4 >> 6;
        for (int rl = wid; rl < 256; rl += 8) { const size_t row = (size_t)pm * 256 + rl;
            const LAS3 f32x4* sp = (const LAS3 f32x4*)(lds + 131072 + rl * 64); const f32x4 s0 = sp[0], s1 = sp[1], s2 = sp[2], s3 = sp[3];
            const float ssq = (((s0[0] + s0[1]) + (s0[2] + s0[3])) + ((s1[0] + s1[1]) + (s1[2] + s1[3]))) + (((s2[0] + s2[1]) + (s2[2] + s2[3])) + ((s3[0] + s3[1]) + (s3[2] + s3[3])));
            const float rstd = rsqrtf(ssq * (1.0f / DM) + EPS);
#pragma unroll
            for (int i = 0; i < 4; ++i) { const int k = 4 * lane + 256 * i; const u32x2 w = *(const u32x2*)(U + row * UP + C_OUT + k);
                const f32x4 xv = *(const f32x4*)(p.x + row * DM + k), gv = *(const f32x4*)(p.g_post + k);
                f32x4 o; o[0] = xv[0] + bf_lo(w.x) * rstd * gv[0]; o[1] = xv[1] + bf_hi(w.x) * rstd * gv[1]; o[2] = xv[2] + bf_lo(w.y) * rstd * gv[2]; o[3] = xv[3] + bf_hi(w.y) * rstd * gv[3];
                *(f32x4*)(p.out + row * DM + k) = o; } }
#ifdef DBG_GCHK
        { int t6 = threadIdx.x; asm volatile("" : "+v"(t6)); const float cdv = ((const float*)(ws + OFF_ROWSS))[(pm & 127) * 512 + t6]; if (cdv > 1.f) p.out[(size_t)pm * 256 * DM + t6] = cdv; }
#endif
#ifdef DBG_WCHK
        {
          int t4 = threadIdx.x; asm volatile("" : "+v"(t4)); int bad = 0;
          for (int e = pm * 512 + t4; e < 3072 * 1024; e += 256 * 512) { const int n = e >> 10, k = e & 1023;
              const float ref = p.w_in[(size_t)k * IN_COLS + 8200 + n]; const unsigned short want = (unsigned short)(pk_bf16(ref, 0.f) & 0xffffu);
              if (WT[(size_t)(8192 + n) * 1024 + k] != want) bad |= 1; }
          for (int e = pm * 512 + t4; e < 3 * 1024 * 1024; e += 256 * 512) { const int w = e >> 20, n = (e >> 10) & 1023, k = e & 1023;
              const float* src = w == 0 ? p.w_a : (w == 1 ? p.w_b : p.w_m); const float ref = k < 512 ? src[(size_t)k * 1024 + n] : 0.f; const unsigned short want = (unsigned short)(pk_bf16(ref, 0.f) & 0xffffu);
              if (((const bf16_t*)(ws + OFF_WP))[(size_t)w * 1024 * 1024 + (size_t)n * 1024 + k] != want) bad |= 2; }
          if (bad) p.out[(size_t)pm * 256 * DM + t4] = 1e4f * bad; }
#endif
        blk_sync_mem();
    }
}

__global__ void __launch_bounds__(512) mega(Params p, int ph_lo, int ph_hi) {
    extern __shared__ __attribute__((aligned(16))) unsigned char smem[];
    LAS3 unsigned char* lds = (LAS3 unsigned char*)smem;
    cg::grid_group grid = cg::this_grid();
#define MK_IN(k) (ph_lo <= (k) && (k) < ph_hi)
#define GSYNC() do { asm volatile("s_waitcnt vmcnt(0) lgkmcnt(0)" ::: "memory"); grid.sync(); __builtin_amdgcn_fence(__ATOMIC_ACQUIRE, "agent"); } while (0)
#ifndef NO_P0
    if (MK_IN(0)) { phase0(p, lds); if (MK_IN(1)) GSYNC(); }
#endif
#ifndef NO_P1
    if (MK_IN(1)) { phase1(p, lds); if (MK_IN(2)) GSYNC(); }
#endif
#ifndef NO_P2
    if (MK_IN(2)) { phase2(p, lds); if (MK_IN(3)) GSYNC(); }
#endif
#ifndef NO_P3
    if (MK_IN(3)) phase3(p, lds);
#endif
}
}

#ifndef MK_N_LAUNCHES
#define MK_N_LAUNCHES 1
#endif
extern "C" void kernel_launch(void* const* d_in, const int* in_sizes, int n_in, void* d_out, int out_size, void* d_ws, size_t ws_size, hipStream_t stream) {
    static int grid = 0;
    if (grid == 0) {
        if (n_in != 14 || in_sizes[0] != mk::NTOK * mk::DM || out_size != mk::NTOK * mk::DM || ws_size < mk::WS_NEED) { fprintf(stderr, "kernel_launch: unexpected shapes / workspace (%zu)\n", ws_size); grid = -1; return; }
        int dev = 0, cus = 0, per_cu = 0;
        hipGetDevice(&dev); hipDeviceGetAttribute(&cus, hipDeviceAttributeMultiprocessorCount, dev);
        hipFuncSetAttribute((const void*)mk::mega, hipFuncAttributeMaxDynamicSharedMemorySize, mk::LDS_BYTES);
        hipOccupancyMaxActiveBlocksPerMultiprocessor(&per_cu, (const void*)mk::mega, 512, mk::LDS_BYTES);
        if (per_cu < 1) per_cu = 1;
        grid = cus * per_cu;
    }
    if (grid < 0) return;
    mk::Params p{};
    p.x = (const float*)d_in[0]; p.mem = (const float*)d_in[1]; p.pos = (const int*)d_in[2]; p.g_pre = (const float*)d_in[3]; p.g_post = (const float*)d_in[4]; p.g_mem = (const float*)d_in[5];
    p.w_in = (const float*)d_in[6]; p.b_forget = (const float*)d_in[7]; p.b_merge = (const float*)d_in[8]; p.w_mem_kv = (const float*)d_in[9]; p.w_a = (const float*)d_in[10]; p.w_b = (const float*)d_in[11];
    p.w_m = (const float*)d_in[12]; p.w_out = (const float*)d_in[13]; p.out = (float*)d_out; p.ws = (unsigned char*)d_ws;
#if MK_N_LAUNCHES == 1
    int lo = 0, hi = 4; void* args[] = {&p, &lo, &hi};
    hipError_t e = hipLaunchCooperativeKernel((const void*)mk::mega, dim3(grid), dim3(512), args, mk::LDS_BYTES, stream);
    if (e != hipSuccess) fprintf(stderr, "cooperative launch failed: %s (grid %d)\n", hipGetErrorString(e), grid);
#else
    for (int ph = 0; ph < 4; ++ph) hipLaunchKernelGGL(mk::mega, dim3(grid), dim3(512), mk::LDS_BYTES, stream, p, ph, ph + 1);
#endif
}
```

```cpp
#include <hip/hip_runtime.h>
#include <hip/hip_cooperative_groups.h>
#include <hip/hip_bf16.h>
#include <cstdio>
#include <cstdint>
#include <cmath>
namespace cg = cooperative_groups;
namespace pg8 {
#define PG8_LAS __attribute__((address_space(3)))
typedef unsigned short bf16_t;
typedef short bf16x8 __attribute__((ext_vector_type(8)));
typedef float f32x4 __attribute__((ext_vector_type(4)));
typedef unsigned u32x4 __attribute__((ext_vector_type(4)));
constexpr int BM = 256, BK = 64, HALF = 128, HTB = HALF * BK * 2  , STAGE_BYTES = 8 * HTB, NXCD = 8, WGM = 4;

__host__ __device__ __forceinline__ int lds_byte(int r, int c) { const int st = (r >> 4) * 2 + (c >> 5), rr = r & 15, cc = c & 31, ob = rr * 64 + cc * 2; return st * 1024 + (ob ^ (((ob >> 9) & 1) << 5)); }
__host__ __device__ __forceinline__ void stage_rc(int b, int& R, int& C) { const int st = b / 1024, sb = b % 1024, swz = sb ^ (((sb >> 9) & 1) << 5); R = (st >> 1) * 16 + swz / 64; C = (st & 1) * 32 + (swz % 64) / 2; }
__host__ __device__ __forceinline__ int perm32(int rho) { const int n = rho >> 4, i = rho & 15; return 8 * (i >> 2) + 4 * n + (i & 3); }

struct Unit { int pm, pn; };
struct Gemm { const bf16_t* A; const bf16_t* Bt; int M, N, K, lda; };

struct StaticOrder {
    int nM, nN, nwg, G, c;
    __host__ __device__ void init(int M, int N, int G_, int c_) { nM = M / BM; nN = N / BM; nwg = nM * nN; G = G_; c = c_; }
    __host__ __device__ bool next(int i, Unit& u) const {
        const long L = (long)i * G + c; if (L >= nwg) return false;
        int wgid = (int)L; { const int q = nwg / NXCD, r = nwg % NXCD, xcd = wgid % NXCD, off = wgid / NXCD; wgid = (xcd < r ? xcd * (q + 1) : r * (q + 1) + (xcd - r) * q) + off; }
        const int nig = WGM * nN, gid = wgid / nig, fm = gid * WGM, gsz = (nM - fm) < WGM ? (nM - fm) : WGM;
        u.pm = fm + ((wgid % nig) % gsz); u.pn = (wgid % nig) / gsz; return true;
    }
    __device__ __forceinline__ void a_ready(const Unit&) const {}
    __device__ __forceinline__ void done(const Unit&) const {}
};

__device__ __forceinline__ unsigned cvt_pk_bf16(float lo, float hi) { unsigned r; asm volatile("v_cvt_pk_bf16_f32 %0, %1, %2" : "=v"(r) : "v"(lo), "v"(hi)); return r; }
typedef float f32x2 __attribute__((ext_vector_type(2)));
template <class Epi, class Sched, bool ALIGN_EPI = false, bool SP2 = false>
__device__ __forceinline__ void gemm_phase(PG8_LAS unsigned char* lds, const Gemm g, const Sched& S, const Epi& E) {
    int tid = threadIdx.x; asm volatile("" : "+v"(tid));
    const int wid = __builtin_amdgcn_readfirstlane(tid >> 6), lane = tid & 63, wr = wid >> 2, wc = wid & 3, fr = lane & 15, fq = lane >> 4;
    const int K = g.K, nt = K / BK;
    unsigned voffA[2], voffB[2];
#pragma unroll
    for (int i = 0; i < 2; ++i) { int R, C; stage_rc(tid * 16 + i * 8192, R, C); const int Rb = Epi::PERM ? ((R & ~31) + perm32(R & 31)) : R;
        voffA[i] = (unsigned)(R * g.lda + C) * 2u; voffB[i] = (unsigned)(Rb * K + C) * 2u; }
    const size_t kstep = (size_t)(BK * 2);
    const size_t hstepA = (size_t)HALF * g.lda * 2, hstepB = (size_t)HALF * K * 2;
    const size_t tstepA = 2 * hstepA, tstepB = 2 * hstepB;
    const unsigned ldsw = (unsigned)wid * 1024u;
    const int aoff = lds_byte(wr * 64 + fr, fq * 8), boff = lds_byte(wc * 32 + fr, fq * 8);
#define PG8_SA(b, h) (((b) * 2 + (h)) * HTB)
#define PG8_SB(b, h) ((4 + (b) * 2 + (h)) * HTB)
#define PG8_STAGE(bufoff, gbase, voff) do { _Pragma("unroll") for (int _i = 0; _i < 2; ++_i) \
        __builtin_amdgcn_global_load_lds((const unsigned*)((const char*)(gbase) + (voff)[_i]), (PG8_LAS unsigned*)(lds + (bufoff) + ldsw + _i * 8192), 16, 0, 0); } while (0)
#define PG8_LDA(dst, b, h) do { _Pragma("unroll") for (int m = 0; m < 4; ++m) _Pragma("unroll") for (int k = 0; k < 2; ++k) dst[m][k] = *(const PG8_LAS bf16x8*)(lds + PG8_SA(b, h) + aoff + m * 2048 + k * 1024); } while (0)
#define PG8_LDB(dst, b, h) do { _Pragma("unroll") for (int n = 0; n < 2; ++n) _Pragma("unroll") for (int k = 0; k < 2; ++k) dst[n][k] = *(const PG8_LAS bf16x8*)(lds + PG8_SB(b, h) + boff + n * 2048 + k * 1024); } while (0)
#define PG8_MMA(ai, bj, At, Bt) do { __builtin_amdgcn_s_setprio(1); _Pragma("unroll") for (int m = 0; m < 4; ++m) _Pragma("unroll") for (int n = 0; n < 2; ++n) _Pragma("unroll") for (int k = 0; k < 2; ++k) \
        acc[ai][bj][m][n] = __builtin_amdgcn_mfma_f32_16x16x32_bf16(Bt[n][k], At[m][k], acc[ai][bj][m][n], 0, 0, 0); __builtin_amdgcn_s_setprio(0); } while (0)
#define PG8_WAIT_V(n) asm volatile("s_waitcnt vmcnt(" #n ")" ::: "memory")
#define PG8_WAIT_L(n) asm volatile("s_waitcnt lgkmcnt(" #n ")" ::: "memory")
#define PG8_BAR __builtin_amdgcn_s_barrier()
#define PG8_SCHED __builtin_amdgcn_sched_barrier(0)
    Unit cur, nxt; int ui = 0;
    if (!S.next(0, cur)) return;
    f32x4 acc[2][2][4][2];
#pragma unroll
    for (int a = 0; a < 2; ++a)
#pragma unroll
        for (int b = 0; b < 2; ++b)
#pragma unroll
            for (int m = 0; m < 4; ++m)
#pragma unroll
                for (int n = 0; n < 2; ++n) acc[a][b][m][n] = (f32x4){0.f, 0.f, 0.f, 0.f};
    bf16x8 At[4][2], B0[2][2], B1[2][2];
    const char* cA = (const char*)g.A + (size_t)cur.pm * tstepA; const char* cB = (const char*)g.Bt + (size_t)cur.pn * tstepB;
    S.a_ready(cur);
    if constexpr (SP2) {
        PG8_STAGE(PG8_SB(0, 0), cB, voffB); PG8_STAGE(PG8_SB(0, 1), cB + hstepB, voffB); PG8_STAGE(PG8_SA(0, 0), cA, voffA); PG8_STAGE(PG8_SA(0, 1), cA + hstepA, voffA);
        if (wr == 1) PG8_BAR;
        PG8_WAIT_V(2); PG8_BAR;
        PG8_STAGE(PG8_SB(1, 0), cB + kstep, voffB); PG8_STAGE(PG8_SA(1, 0), cA + kstep, voffA); PG8_STAGE(PG8_SB(1, 1), cB + hstepB + kstep, voffB);
        PG8_WAIT_V(6); PG8_BAR;
    } else {
        PG8_STAGE(PG8_SB(0, 0), cB, voffB); PG8_STAGE(PG8_SA(0, 0), cA, voffA); PG8_STAGE(PG8_SB(0, 1), cB + hstepB, voffB); PG8_STAGE(PG8_SA(0, 1), cA + hstepA, voffA);
        if (wr == 1) PG8_BAR;
        PG8_WAIT_V(4); PG8_BAR;
        PG8_STAGE(PG8_SB(1, 0), cB + kstep, voffB); PG8_STAGE(PG8_SA(1, 0), cA + kstep, voffA); PG8_STAGE(PG8_SB(1, 1), cB + hstepB + kstep, voffB);
        PG8_WAIT_V(6); PG8_BAR;
    }
    for (;;) {
        const bool has_next = S.next(ui + 1, nxt);
        const char* nA = has_next ? (const char*)g.A + (size_t)nxt.pm * tstepA : cA; const char* nB = has_next ? (const char*)g.Bt + (size_t)nxt.pn * tstepB : cB;
        for (int t = 0; t < nt; t += 2) {
            const bool last = (t == nt - 2);
            const char* a1 = cA + (size_t)(t + 1) * kstep;
            const char* a2 = last ? nA : cA + (size_t)(t + 2) * kstep; const char* b2 = last ? nB : cB + (size_t)(t + 2) * kstep;
            const char* a3 = a2 + kstep; const char* b3 = b2 + kstep;
            if (last && has_next) S.a_ready(nxt);
            if constexpr (SP2) {
            PG8_LDB(B0, 0, 0); PG8_LDB(B1, 0, 1); PG8_SCHED; PG8_LDA(At, 0, 0); PG8_STAGE(PG8_SA(1, 1), a1 + hstepA, voffA);
            PG8_WAIT_V(8); PG8_WAIT_L(0); PG8_BAR; PG8_MMA(0, 0, At, B0); PG8_MMA(0, 1, At, B1); PG8_BAR; PG8_SCHED;
            PG8_LDA(At, 0, 1); PG8_STAGE(PG8_SB(0, 0), b2, voffB); PG8_STAGE(PG8_SB(0, 1), b2 + hstepB, voffB); PG8_STAGE(PG8_SA(0, 0), a2, voffA);
            PG8_WAIT_V(8); PG8_WAIT_L(0); PG8_BAR; PG8_MMA(1, 0, At, B0); PG8_MMA(1, 1, At, B1); PG8_BAR; PG8_SCHED;
            PG8_LDB(B0, 1, 0); PG8_LDB(B1, 1, 1); PG8_SCHED; PG8_LDA(At, 1, 0); PG8_STAGE(PG8_SA(0, 1), a2 + hstepA, voffA);
            PG8_WAIT_V(8); PG8_WAIT_L(0); PG8_BAR; PG8_MMA(0, 0, At, B0); PG8_MMA(0, 1, At, B1); PG8_BAR; PG8_SCHED;
            PG8_LDA(At, 1, 1); PG8_STAGE(PG8_SB(1, 0), b3, voffB); PG8_STAGE(PG8_SB(1, 1), b3 + hstepB, voffB); PG8_STAGE(PG8_SA(1, 0), a3, voffA);
            PG8_WAIT_V(8); PG8_WAIT_L(0); PG8_BAR; PG8_MMA(1, 0, At, B0); PG8_MMA(1, 1, At, B1); PG8_BAR; PG8_SCHED;
            } else {
            PG8_LDB(B0, 0, 0); PG8_SCHED; PG8_LDA(At, 0, 0); PG8_STAGE(PG8_SA(1, 1), a1 + hstepA, voffA);
            PG8_WAIT_L(8); PG8_BAR; PG8_WAIT_L(0); PG8_MMA(0, 0, At, B0); PG8_BAR; PG8_SCHED;
            PG8_LDB(B1, 0, 1); PG8_STAGE(PG8_SB(0, 0), b2, voffB);
            PG8_BAR; PG8_WAIT_L(0); PG8_MMA(0, 1, At, B1); PG8_BAR;
            PG8_LDA(At, 0, 1); PG8_STAGE(PG8_SA(0, 0), a2, voffA);
            PG8_BAR; PG8_WAIT_L(0); PG8_MMA(1, 0, At, B0); PG8_BAR; PG8_SCHED;
            PG8_STAGE(PG8_SB(0, 1), b2 + hstepB, voffB);
            PG8_WAIT_V(6); PG8_BAR; PG8_MMA(1, 1, At, B1); PG8_BAR;
            PG8_LDB(B0, 1, 0); PG8_SCHED; PG8_LDA(At, 1, 0); PG8_STAGE(PG8_SA(0, 1), a2 + hstepA, voffA);
            PG8_WAIT_L(8); PG8_BAR; PG8_WAIT_L(0); PG8_MMA(0, 0, At, B0); PG8_BAR; PG8_SCHED;
            PG8_LDB(B1, 1, 1); PG8_STAGE(PG8_SB(1, 0), b3, voffB);
            PG8_BAR; PG8_WAIT_L(0); PG8_MMA(0, 1, At, B1); PG8_BAR;
            PG8_LDA(At, 1, 1); PG8_STAGE(PG8_SA(1, 0), a3, voffA);
            PG8_BAR; PG8_WAIT_L(0); PG8_MMA(1, 0, At, B0); PG8_BAR; PG8_SCHED;
            PG8_STAGE(PG8_SB(1, 1), b3 + hstepB, voffB);
            PG8_WAIT_V(6); PG8_BAR; PG8_MMA(1, 1, At, B1); PG8_BAR;
            }
        }
        if constexpr (ALIGN_EPI) { if (wr == 0) PG8_BAR; }
        if constexpr (!Epi::AFTER_DRAIN) { E(acc, cur, wr, wc, fr, fq, lane); S.done(cur); }
        if (!has_next) break;
#pragma unroll
        for (int a = 0; a < 2; ++a)
#pragma unroll
            for (int b = 0; b < 2; ++b)
#pragma unroll
                for (int m = 0; m < 4; ++m)
#pragma unroll
                    for (int n = 0; n < 2; ++n) acc[a][b][m][n] = (f32x4){0.f, 0.f, 0.f, 0.f};
        cur = nxt; cA = nA; cB = nB; ++ui;
        if constexpr (ALIGN_EPI) { if (wr == 1) PG8_BAR; }
    }
    PG8_WAIT_V(0);
    if constexpr (!ALIGN_EPI) { if (wr == 0) PG8_BAR; }
    PG8_BAR;
    if constexpr (Epi::AFTER_DRAIN) { E.fused(acc, cur, wr, wc, fr, fq, lds, wid, lane); S.done(cur); }
#undef PG8_SA
#undef PG8_SB
#undef PG8_STAGE
#undef PG8_LDA
#undef PG8_LDB
#undef PG8_MMA
#undef PG8_WAIT_V
#undef PG8_WAIT_L
#undef PG8_BAR
#undef PG8_SCHED
}
}
#define PG8_SP2 true
#include <hip/hip_bf16.h>
#include <cmath>
namespace attn_body {
using bf16=__hip_bfloat16;
using bf16x8=__attribute__((ext_vector_type(8)))short;
using s16x4=__attribute__((ext_vector_type(4)))short;
using f32x16=__attribute__((ext_vector_type(16)))float;
using u32x4=__attribute__((ext_vector_type(4)))unsigned;
using f32x4v=__attribute__((ext_vector_type(4)))float;
constexpr int BATCH=8,NHEAD=8,SEQ=8192,D=64,DM=6656;
constexpr int NW=8,QBLK=32,QB=QBLK*NW,KVBLK=64,NQB=SEQ/QB;
constexpr int ATTN_PITCH=DM, ATTN_UNIT_ROWS=QB;
__device__ __forceinline__ int crow(int r,int hi){return (r&3)+8*(r>>2)+4*hi;}
#define SBAR() __builtin_amdgcn_sched_barrier(0)
__device__ __forceinline__ void cmask(f32x16&p0,f32x16&p1,int jb,int qrel,int hi){
  const float NEG=-INFINITY; int kb=64*jb+4*hi;
  #pragma unroll
  for(int r=0;r<16;++r){int kv=kb+(r&3)+8*(r>>2); if(kv>qrel)p0[r]=NEG; if(kv+32>qrel)p1[r]=NEG;}
}

constexpr int NSLOT=3, SLOTB=8192;
constexpr int LDS_K=0, LDS_V=NSLOT*SLOTB, LDS_WS=2*NSLOT*SLOTB, LDS_OST=LDS_WS+NW*64*4, LDS_CB=LDS_OST+NW*4096, LDS_BYTES=LDS_CB+SEQ*4;
constexpr float C2=0.125f*1.4426950408889634f;
__device__ __forceinline__ void glds16(const void*gsrc,unsigned lds_dst){unsigned keep;
  asm volatile("s_mov_b32 %0, m0\n\ts_mov_b32 m0, %2\n\ts_nop 0\n\tglobal_load_lds_dwordx4 %1, off\n\ts_mov_b32 m0, %0":"=&s"(keep):"v"(gsrc),"s"(lds_dst):"memory");}
__device__ __forceinline__ float max3f(float a,float b,float c){float r;asm("v_max3_f32 %0, %1, %2, %3":"=v"(r):"v"(a),"v"(b),"v"(c));return r;}
__device__ __forceinline__ float max2f(float a,float b){float r;asm("v_max_f32_e32 %0, %1, %2":"=v"(r):"v"(a),"v"(b));return r;}
__device__ __forceinline__ float fadd_s(float a,float b){float r;asm("v_add_f32_e32 %0, %1, %2":"=v"(r):"v"(a),"v"(b));return r;}
__device__ __forceinline__ float fsub_s(float a,float b){float r;asm("v_sub_f32_e32 %0, %1, %2":"=v"(r):"v"(a),"v"(b));return r;}
typedef float f32x2_t __attribute__((ext_vector_type(2))); typedef __bf16 bf16x2_t __attribute__((ext_vector_type(2)));
__device__ __forceinline__ unsigned cvtpk_s(float lo,float hi){f32x2_t v={lo,hi};bf16x2_t b=__builtin_convertvector(v,bf16x2_t);return __builtin_bit_cast(unsigned,b);}
#define WAIT_BAR(N) asm volatile("s_waitcnt vmcnt(" #N ") lgkmcnt(0)\n\ts_barrier":::"memory")

__device__ __forceinline__ void qkt(f32x16&p0,f32x16&p1,const char*Kslot,const bf16x8*qr,const f32x16&negm,int r32,int hi){
  const char*kb=Kslot+hi*1024+r32*16;
  #pragma unroll
  for(int d0=0;d0<4;++d0){
    const bf16x8 b0=*reinterpret_cast<const bf16x8*>(kb+d0*2048);
    const bf16x8 b1=*reinterpret_cast<const bf16x8*>(kb+d0*2048+512);
    if(d0==0){p0=__builtin_amdgcn_mfma_f32_32x32x16_bf16(b0,qr[0],negm,0,0,0);p1=__builtin_amdgcn_mfma_f32_32x32x16_bf16(b1,qr[0],negm,0,0,0);}
    else{p0=__builtin_amdgcn_mfma_f32_32x32x16_bf16(b0,qr[d0],p0,0,0,0);p1=__builtin_amdgcn_mfma_f32_32x32x16_bf16(b1,qr[d0],p1,0,0,0);}}
}
typedef __attribute__((address_space(3))) const char* lds_cptr;
typedef short v4i16_t __attribute__((ext_vector_type(4)));
__device__ __forceinline__ void kload8(bf16x8*kf,lds_cptr kp){
  kf[0]=*(const __attribute__((address_space(3))) bf16x8*)(kp);      kf[1]=*(const __attribute__((address_space(3))) bf16x8*)(kp+512);
  kf[2]=*(const __attribute__((address_space(3))) bf16x8*)(kp+2048); kf[3]=*(const __attribute__((address_space(3))) bf16x8*)(kp+2560);
  kf[4]=*(const __attribute__((address_space(3))) bf16x8*)(kp+4096); kf[5]=*(const __attribute__((address_space(3))) bf16x8*)(kp+4608);
  kf[6]=*(const __attribute__((address_space(3))) bf16x8*)(kp+6144); kf[7]=*(const __attribute__((address_space(3))) bf16x8*)(kp+6656);
}
__device__ __forceinline__ void kload2(bf16x8*kf,lds_cptr kp,int j){ kf[2*j]=*(const __attribute__((address_space(3))) bf16x8*)(kp+j*2048); kf[2*j+1]=*(const __attribute__((address_space(3))) bf16x8*)(kp+j*2048+512); }
__device__ __forceinline__ s16x4 vtr(lds_cptr p){ return __builtin_bit_cast(s16x4,__builtin_amdgcn_ds_read_tr16_b64_v4i16((__attribute__((address_space(3))) v4i16_t*)p)); }
__device__ __forceinline__ float rowmax(const f32x16&p0,const f32x16&p1){
  float a=max3f(p0[0],p0[1],p1[0]),b=max3f(p0[2],p0[3],p1[1]);a=max3f(a,p1[2],p1[3]);
  #pragma unroll
  for(int r=4;r<16;r+=4){a=max3f(a,p0[r],p0[r+1]);b=max3f(b,p0[r+2],p0[r+3]);a=max3f(a,p1[r],p1[r+1]);b=max3f(b,p1[r+2],p1[r+3]);}
  const float m=max2f(a,b);
  auto rr=__builtin_amdgcn_permlane32_swap(__float_as_uint(m),__float_as_uint(m),false,false);
  return max2f(__uint_as_float(rr[0]),__uint_as_float(rr[1]));
}
__device__ __forceinline__ void pv(f32x16*o,int vb,bf16x8 pa0,bf16x8 pa1,bf16x8 pa2,bf16x8 pa3){
  #pragma unroll
  for(int d0=0;d0<2;++d0){s16x4 lo[4],hi[4];
    #pragma unroll
    for(int ks=0;ks<4;++ks){
      asm volatile("ds_read_b64_tr_b16 %0,%1 offset:%c2":"=&v"(lo[ks]):"v"(vb),"i"(d0*4096+ks*1024):"memory");
      asm volatile("ds_read_b64_tr_b16 %0,%1 offset:%c2":"=&v"(hi[ks]):"v"(vb),"i"(d0*4096+ks*1024+512):"memory");}
    asm volatile("s_waitcnt lgkmcnt(0)":::"memory");SBAR();
    #define PK(k) (bf16x8){lo[k][0],lo[k][1],lo[k][2],lo[k][3],hi[k][0],hi[k][1],hi[k][2],hi[k][3]}
    o[d0]=__builtin_amdgcn_mfma_f32_32x32x16_bf16(pa0,PK(0),o[d0],0,0,0);
    o[d0]=__builtin_amdgcn_mfma_f32_32x32x16_bf16(pa1,PK(1),o[d0],0,0,0);
    o[d0]=__builtin_amdgcn_mfma_f32_32x32x16_bf16(pa2,PK(2),o[d0],0,0,0);
    o[d0]=__builtin_amdgcn_mfma_f32_32x32x16_bf16(pa3,PK(3),o[d0],0,0,0);
    #undef PK
  }
}

#ifndef ATTN_STORE16
#define ATTN_STORE16(p,v) (*(u32x4*)(p)=(v))
#endif
template<int THRL> __device__ __forceinline__ void attn_unit(int b,int h,int qb,const bf16*Q,const bf16*__restrict__ K,const bf16*__restrict__ V,bf16*O,const float*__restrict__ CB,const float*__restrict__ NRM,char*shm){
  const int tid=threadIdx.x,lane=tid&63,r32=lane&31,hi=lane>>5; const int wid=__builtin_amdgcn_readfirstlane(tid>>6);
  const long rowbase=(long)b*SEQ; const int q0=qb*QB;
  const bf16*Qw=Q+(rowbase+q0+wid*QBLK)*DM+h*D;
  int ts;
  { const float*cbg0=CB+(long)(b*NHEAD+h)*SEQ; const float*nq=NRM+((b*8+h)*32+qb)*2,*nk=NRM+4096+(b*8+h)*2;
    const float q0s=__uint_as_float(__hip_atomic_load((const unsigned*)nq,__ATOMIC_RELAXED,__HIP_MEMORY_SCOPE_AGENT)),q1s=__uint_as_float(__hip_atomic_load((const unsigned*)nq+1,__ATOMIC_RELAXED,__HIP_MEMORY_SCOPE_AGENT)),k0s=__uint_as_float(__hip_atomic_load((const unsigned*)nk,__ATOMIC_RELAXED,__HIP_MEMORY_SCOPE_AGENT)),k1s=__uint_as_float(__hip_atomic_load((const unsigned*)nk+1,__ATOMIC_RELAXED,__HIP_MEMORY_SCOPE_AGENT));
    const float thr=2.02f*(sqrtf(q0s*k0s)+sqrtf(q1s*k1s))+24.0f; const int ntf=(q0+QB)/KVBLK; const int tc=2*(lane+1);
    bool ok=false; if(tc<=ntf-4) ok=(cbg0[q0]-cbg0[64*tc-1])>=thr;
    ts=2*__builtin_popcountll(__ballot(ok)); ts=__builtin_amdgcn_readfirstlane(ts); }
  const bf16*Kh=K+(rowbase+(long)ts*KVBLK)*DM+h*D,*Vh=V+(rowbase+(long)ts*KVBLK)*DM+h*D;
  const unsigned lds0=(unsigned)(uintptr_t)shm;
  float*wsf=(float*)(shm+LDS_WS)+wid*64;
  const bf16*ksrc=Kh+(long)lane*DM+wid*8;
  const bf16*vsrc=Vh+(long)(16*(wid&3)+(lane>>2))*DM+(wid>>2)*32+(lane&3)*8;
  const unsigned kdst=lds0+LDS_K+wid*1024, vdst=lds0+LDS_V+wid*1024;
  #define DMA_K(t,slot) glds16(ksrc+(long)(t)*KVBLK*DM,(unsigned)__builtin_amdgcn_readfirstlane(kdst+(slot)))
  #define DMA_V(t,slot) glds16(vsrc+(long)(t)*KVBLK*DM,(unsigned)__builtin_amdgcn_readfirstlane(vdst+(slot)))
  const int vb0=(int)(lds0+LDS_V)+((lane>>4)&1)*32+(lane&3)*8+(4*hi+((lane&15)>>2))*64;
  const char*Kbase=shm+LDS_K; bf16x8 kf[8];
  const lds_cptr shm3=(lds_cptr)shm; const lds_cptr kp0=shm3+LDS_K+hi*1024+r32*16; const lds_cptr vp0=shm3+LDS_V+((lane>>4)&1)*32+(lane&3)*8+(4*hi+((lane&15)>>2))*64;
  const int NT=(q0+QB)/KVBLK-ts;
  { const float*cbg=CB+(long)(b*NHEAD+h)*SEQ+ts*KVBLK; __attribute__((address_space(3))) float*cbl=(__attribute__((address_space(3))) float*)((lds_cptr)shm+LDS_CB);
    for(int i=tid*4;i<q0+QB-ts*KVBLK;i+=2048){ const f32x4v v=*reinterpret_cast<const f32x4v*>(cbg+i); *(__attribute__((address_space(3))) f32x4v*)(cbl+i)=v; } }
  const __attribute__((address_space(3))) float*cbw=(const __attribute__((address_space(3))) float*)((lds_cptr)shm+LDS_CB)+4*hi;
  #define BIAS(P0,P1,t) do{ const __attribute__((address_space(3))) float*cp_=cbw+64*(t); _Pragma("unroll") for(int j_=0;j_<4;++j_){ const f32x4v a_=*(const __attribute__((address_space(3))) f32x4v*)(cp_+8*j_); const f32x4v b_=*(const __attribute__((address_space(3))) f32x4v*)(cp_+32+8*j_); \
      P0[4*j_]+=a_[0];P0[4*j_+1]+=a_[1];P0[4*j_+2]+=a_[2];P0[4*j_+3]+=a_[3]; P1[4*j_]+=b_[0];P1[4*j_+1]+=b_[1];P1[4*j_+2]+=b_[2];P1[4*j_+3]+=b_[3]; } }while(0)
  #define BLOAD(P0,P1,t) do{ const __attribute__((address_space(3))) float*cp_=cbw+64*(t); _Pragma("unroll") for(int j_=0;j_<4;++j_){ const f32x4v a_=*(const __attribute__((address_space(3))) f32x4v*)(cp_+8*j_); const f32x4v b_=*(const __attribute__((address_space(3))) f32x4v*)(cp_+32+8*j_); \
      P0[4*j_]=a_[0];P0[4*j_+1]=a_[1];P0[4*j_+2]=a_[2];P0[4*j_+3]=a_[3]; P1[4*j_]=b_[0];P1[4*j_+1]=b_[1];P1[4*j_+2]=b_[2];P1[4*j_+3]=b_[3]; } }while(0)
  #define BSUB(P0,P1) do{ _Pragma("unroll") for(int r_=0;r_<16;++r_){P0[r_]-=mhat;P1[r_]-=mhat;} }while(0)
  DMA_K(0,0);DMA_V(0,0);DMA_K(1,SLOTB);
  bf16x8 qr[4];
  #pragma unroll
  for(int d0=0;d0<4;++d0)qr[d0]=*reinterpret_cast<const bf16x8*>(&Qw[(long)r32*DM+d0*16+hi*8]);
  float mhat=0.f,l_reg=0.f;f32x16 o[2];o[0]=f32x16{};o[1]=f32x16{};f32x16 negm=f32x16{};asm volatile("":"+v"(negm));
  const int qrel=wid*QBLK+r32;
  #define CMASK(P0,P1,t) do{int jb_=(t)-(NT-4); if(jb_>=0)cmask(P0,P1,jb_,qrel,hi);}while(0)
  bool resc=false;
  #define START(P0,P1) do{ const float rm=rowmax(P0,P1); resc=false; \
    { const float dl=rm; mhat=fadd_s(mhat,dl); \
      _Pragma("unroll") for(int r=0;r<16;++r){P0[r]=fsub_s(P0[r],dl);P1[r]=fsub_s(P1[r],dl);} \
      } \
    _Pragma("unroll") for(int r=0;r<16;++r)P0[r]=__builtin_amdgcn_exp2f(P0[r]); }while(0)
  #define RESC() do{ if(resc){ asm volatile("s_waitcnt lgkmcnt(0)":::"memory"); \
      _Pragma("unroll") for(int d_=0;d_<2;++d_) _Pragma("unroll") for(int r=0;r<16;++r)o[d_][r]*=wsf[crow(r,hi)]; } }while(0)
  f32x16 pA0,pA1,pB0,pB1;
  int sl_prev=0,sl_cur=0,sl_next=SLOTB;
  #define ROT() do{sl_prev=sl_cur;sl_cur=sl_next;sl_next=(sl_next==(NSLOT-1)*SLOTB)?0:sl_next+SLOTB;}while(0)
  DMA_K(2,2*SLOTB);
  WAIT_BAR(3);
  qkt(pA0,pA1,Kbase,qr,negm,r32,hi);asm volatile("s_nop 15\n\ts_nop 7":"+v"(pA0),"+v"(pA1));BIAS(pA0,pA1,0);CMASK(pA0,pA1,0);
  START(pA0,pA1);
  _Pragma("unroll") for(int r=0;r<16;++r)pA1[r]=__builtin_amdgcn_exp2f(pA1[r]);
  WAIT_BAR(0);
  DMA_K(3,0);DMA_V(1,SLOTB);
  ROT();
  BLOAD(pB0,pB1,1); BSUB(pB0,pB1);
  kload8(kf,kp0+sl_cur);
  WAIT_BAR(2);
  s16x4 vlo[8],vhi[8]; u32x4 pw0,pw1,pw2,pw3;
  #define PKW(P,B) cvtpk_s(P[B],P[B+1])
  #define PAF(k) __builtin_bit_cast(bf16x8,pw##k)
  #define VFR(i) (bf16x8){vlo[i][0],vlo[i][1],vlo[i][2],vlo[i][3],vhi[i][0],vhi[i][1],vhi[i][2],vhi[i][3]}
  #define PIN(x) asm volatile("":"+v"(x))
  #define MX3(a,b,c) __builtin_fmaxf(__builtin_fmaxf((a),(b)),(c))
  #define GAPA(MF,A0,A1,A2,A3,W0,W1,PW) do{ MF; sacc+=A0; sacc+=A1; sacc+=A2; sacc+=A3; PIN(sacc); W0; W1; PIN(PW); SBAR(); }while(0)
  #define EX(v) __builtin_amdgcn_exp2f(v)
  #define GAPB(MF,X,B) do{ MF; X[B]=EX(X[B]); X[B+1]=EX(X[B+1]); X[B+2]=EX(X[B+2]); X[B+3]=EX(X[B+3]); PIN(X); SBAR(); }while(0)
  #define VRD(i) do{ vlo[i]=vtr(vp_+(((i)>>2)*4096+((i)&3)*1024)); vhi[i]=vtr(vp_+(((i)>>2)*4096+((i)&3)*1024+512)); }while(0)
  #define KRD(G,j) do{ if(G){ kload2(kf,kp0+sl_next,j); SBAR(); } }while(0)
  #define STEP(C0,C1,P0,P1,t,GK,GV,GL) do{ SBAR(); \
    const lds_cptr vp_=vp0+sl_prev; \
    VRD(0); SBAR(); float sacc=(P0[0]+P0[1]); \
    GAPA(C0=__builtin_amdgcn_mfma_f32_32x32x16_bf16(kf[0],qr[0],C0,0,0,0), P0[2],P0[3],P0[4],P0[5],     pw0[0]=PKW(P0,0), pw0[1]=PKW(P0,2), pw0); \
    VRD(4); SBAR(); GAPA(C1=__builtin_amdgcn_mfma_f32_32x32x16_bf16(kf[1],qr[0],C1,0,0,0), P0[6],P0[7],P0[8],P0[9],     pw0[2]=PKW(P0,4), pw0[3]=PKW(P0,6), pw0); \
    VRD(1); SBAR(); GAPA(C0=__builtin_amdgcn_mfma_f32_32x32x16_bf16(kf[2],qr[1],C0,0,0,0),   P0[10],P0[11],P0[12],P0[13], pw1[0]=PKW(P0,8), pw1[1]=PKW(P0,10), pw1); \
    VRD(5); SBAR(); GAPA(C1=__builtin_amdgcn_mfma_f32_32x32x16_bf16(kf[3],qr[1],C1,0,0,0),   P0[14],P0[15],P1[0],P1[1],   pw1[2]=PKW(P0,12),pw1[3]=PKW(P0,14), pw1); \
    VRD(2); SBAR(); GAPA(C0=__builtin_amdgcn_mfma_f32_32x32x16_bf16(kf[4],qr[2],C0,0,0,0),   P1[2],P1[3],P1[4],P1[5],     pw2[0]=PKW(P1,0), pw2[1]=PKW(P1,2), pw2); \
    VRD(6); SBAR(); GAPA(C1=__builtin_amdgcn_mfma_f32_32x32x16_bf16(kf[5],qr[2],C1,0,0,0),   P1[6],P1[7],P1[8],P1[9],     pw2[2]=PKW(P1,4), pw2[3]=PKW(P1,6), pw2); \
    VRD(3); SBAR(); GAPA(C0=__builtin_amdgcn_mfma_f32_32x32x16_bf16(kf[6],qr[3],C0,0,0,0),   P1[10],P1[11],P1[12],P1[13], pw3[0]=PKW(P1,8), pw3[1]=PKW(P1,10), pw3); \
    VRD(7); SBAR(); GAPA(C1=__builtin_amdgcn_mfma_f32_32x32x16_bf16(kf[7],qr[3],C1,0,0,0),   P1[14],P1[15],0.f,0.f,       pw3[2]=PKW(P1,12),pw3[3]=PKW(P1,14), pw3); \
    l_reg+=sacc; \
    if(GK){DMA_K((t)+3,sl_cur);} if(GV){DMA_V((t)+1,sl_next);} \
    CMASK(C0,C1,t); \
    { float a=MX3(C0[0],C0[1],C1[0]),b=MX3(C0[2],C0[3],C1[1]); a=MX3(a,C1[2],C1[3]); \
      _Pragma("unroll") for(int r=4;r<16;r+=4){a=MX3(a,C0[r],C0[r+1]);b=MX3(b,C0[r+2],C0[r+3]);a=MX3(a,C1[r],C1[r+1]);b=MX3(b,C1[r+2],C1[r+3]);} \
      float rm=__builtin_fmaxf(a,b); { auto rr=__builtin_amdgcn_permlane32_swap(__float_as_uint(rm),__float_as_uint(rm),false,false); rm=__builtin_fmaxf(__uint_as_float(rr[0]),__uint_as_float(rr[1])); } \
      resc=false; \
      if(__builtin_expect(__any(rm>(float)THRL),0)){ const float dl=__builtin_fmaxf(rm,0.f); mhat+=dl; \
        _Pragma("unroll") for(int r=0;r<16;++r){C0[r]-=dl;C1[r]-=dl;} \
        const float f=__builtin_amdgcn_exp2f(-dl); l_reg*=f; if(hi==0)wsf[r32]=f; resc=true; } } \
    SBAR(); BLOAD(P0,P1,(t)+1); SBAR(); \
    GAPB(o[0]=__builtin_amdgcn_mfma_f32_32x32x16_bf16(PAF(0),VFR(0),o[0],0,0,0), C0,0); \
    GAPB(o[1]=__builtin_amdgcn_mfma_f32_32x32x16_bf16(PAF(0),VFR(4),o[1],0,0,0), C0,4); \
    KRD(GL,0); GAPB(o[0]=__builtin_amdgcn_mfma_f32_32x32x16_bf16(PAF(1),VFR(1),o[0],0,0,0), C0,8); \
    KRD(GL,1); GAPB(o[1]=__builtin_amdgcn_mfma_f32_32x32x16_bf16(PAF(1),VFR(5),o[1],0,0,0), C0,12); \
    KRD(GL,2); GAPB(o[0]=__builtin_amdgcn_mfma_f32_32x32x16_bf16(PAF(2),VFR(2),o[0],0,0,0), C1,0); \
    KRD(GL,3); GAPB(o[1]=__builtin_amdgcn_mfma_f32_32x32x16_bf16(PAF(2),VFR(6),o[1],0,0,0), C1,4); \
    GAPB(o[0]=__builtin_amdgcn_mfma_f32_32x32x16_bf16(PAF(3),VFR(3),o[0],0,0,0), C1,8); \
    GAPB(o[1]=__builtin_amdgcn_mfma_f32_32x32x16_bf16(PAF(3),VFR(7),o[1],0,0,0), C1,12); \
    BSUB(P0,P1); \
    }while(0)
  int t=1;
  #undef CMASK
  #define CMASK(P0,P1,t) do{}while(0)
  for(;t+5<NT;t+=2){
    STEP(pB0,pB1,pA0,pA1,t,true,true,true);     WAIT_BAR(2); RESC(); ROT();
    STEP(pA0,pA1,pB0,pB1,t+1,true,true,true);   WAIT_BAR(2); RESC(); ROT();
  }
  #undef CMASK
  #define CMASK(P0,P1,t) do{int jb_=(t)-(NT-4); if(jb_>=0)cmask(P0,P1,jb_,qrel,hi);}while(0)
  #define ENDW(tt) do{ if((tt)+3<NT){WAIT_BAR(2);} else if((tt)+2<NT){WAIT_BAR(1);} else {WAIT_BAR(0);} }while(0)
  for(;t+1<NT;t+=2){
    STEP(pB0,pB1,pA0,pA1,t,(t+3<NT),(t+1<NT),(t+1<NT));       ENDW(t);   RESC(); ROT();
    STEP(pA0,pA1,pB0,pB1,t+1,(t+4<NT),(t+2<NT),(t+2<NT));     ENDW(t+1); RESC(); ROT();
  }
  STEP(pB0,pB1,pA0,pA1,NT-1,false,false,false); RESC();
  { float sacc=pB0[0]+pB0[1]; _Pragma("unroll") for(int r=2;r<16;++r)sacc+=pB0[r]; _Pragma("unroll") for(int r=0;r<16;++r)sacc+=pB1[r]; l_reg+=sacc;
    pw0=(u32x4){PKW(pB0,0),PKW(pB0,2),PKW(pB0,4),PKW(pB0,6)};pw1=(u32x4){PKW(pB0,8),PKW(pB0,10),PKW(pB0,12),PKW(pB0,14)};pw2=(u32x4){PKW(pB1,0),PKW(pB1,2),PKW(pB1,4),PKW(pB1,6)};pw3=(u32x4){PKW(pB1,8),PKW(pB1,10),PKW(pB1,12),PKW(pB1,14)};
    SBAR(); pv(o,vb0+sl_cur,PAF(0),PAF(1),PAF(2),PAF(3)); }
  #undef PKW
  #undef PAF
  #undef VFR
  #undef PIN
  #undef MX3
  #undef GAPA
  #undef GAPB
  #undef EX
  #undef VRD
  #undef KRD
  #undef STEP
  #undef ENDW
  {auto rr=__builtin_amdgcn_permlane32_swap(__float_as_uint(l_reg),__float_as_uint(l_reg),false,false);l_reg=__uint_as_float(rr[0])+__uint_as_float(rr[1]);}
  if(hi==0)wsf[32+r32]=l_reg;asm volatile("s_waitcnt lgkmcnt(0)":::"memory");
  float rli[16];
  #pragma unroll
  for(int r=0;r<16;++r)rli[r]=__builtin_amdgcn_rcpf(wsf[32+crow(r,hi)]);
  bf16*Ow=O+(rowbase+q0+wid*QBLK)*DM+h*D;
  { bf16*stg=(bf16*)(shm+LDS_OST)+wid*2048;
    #pragma unroll
    for(int r=0;r<16;++r){const int orow=crow(r,hi);
      #pragma unroll
      for(int d0=0;d0<2;++d0)stg[orow*64+d0*32+r32]=__float2bfloat16(o[d0][r]*rli[r]);}
    asm volatile("s_waitcnt lgkmcnt(0)":::"memory");
    #pragma unroll
    for(int i=0;i<4;++i){const int row=i*8+(lane>>3),ch=lane&7; const u32x4 v=*(const u32x4*)(stg+row*64+ch*8); ATTN_STORE16(Ow+(long)row*DM+ch*8,v);} }
  asm volatile("s_waitcnt lgkmcnt(0)\n\ts_barrier":::"memory");
  #undef DMA_K
  #undef BIAS
  #undef BLOAD
  #undef BSUB
  #undef DMA_V
  #undef CMASK
  #undef START
  #undef RESC
  #undef ROT
}
constexpr int ATTN_LDS_BYTES=LDS_BYTES;
struct AttnTensors { const bf16* Q; const bf16* K; const bf16* V; bf16* O; const float* CB; const float* NRM; };
struct AttnUnit { int bh; int qb; };
struct StaticOrder {
  int g,c;
  __device__ __forceinline__ explicit StaticOrder(int grid,int block):g(grid),c(block){}
  __device__ __forceinline__ bool next(int i,AttnUnit&u)const{
    if(g==256){ if(i>=8)return false; const int cc=c>>3; u.bh=(c&7)*8+i; u.qb=(cc+4*i)&31; return true; }
    const int e=c+i*g; if(e>=2048)return false; u.bh=e&63; u.qb=31-(e>>6); return true; }
  __device__ __forceinline__ void a_ready(const AttnUnit&)const{}
  __device__ __forceinline__ void done(const AttnUnit&)const{}
};
template<class Sched,int THRL=40> __device__ __forceinline__ void attn_phase(char*lds,const AttnTensors&T,const Sched&S){
  AttnUnit u;
  for(int i=0;S.next(i,u);++i){ S.a_ready(u); attn_unit<THRL>(u.bh/NHEAD,u.bh%NHEAD,u.qb,T.Q,T.K,T.V,T.O,T.CB,T.NRM,lds); S.done(u); }
}
#undef SBAR
#undef WAIT_BAR
}
namespace mk {
#define LAS3 __attribute__((address_space(3)))
typedef unsigned short bf16_t;
typedef short bf16x8 __attribute__((ext_vector_type(8)));
typedef float f32x4 __attribute__((ext_vector_type(4)));
typedef unsigned u32x4 __attribute__((ext_vector_type(4)));
typedef unsigned u32x2 __attribute__((ext_vector_type(2)));
constexpr int NB = 8, S = 8192, DM = 1024, NTOK = NB * S, NMEM = 256;
constexpr int IN_COLS = 11272, UP = 6656;
constexpr int C_QA = 0, C_KA = 1536, C_VA = 3072, C_QB = 4608, C_KB = 5120, C_VB = 5632, C_QM = 6144, C_OUT = 512;
constexpr float EPS = 1e-6f, LOG2E = 1.4426950408889634f;
constexpr float SC128 = 0.08838834764831845f * LOG2E;
constexpr float SC64 = 0.125f * LOG2E;
constexpr size_t MiB = 1u << 20;
constexpr size_t OFF_U = 0, OFF_H = 832 * MiB, OFF_WT = 960 * MiB, OFF_WA = 982 * MiB, OFF_WB = 983 * MiB, OFF_WM = 984 * MiB, OFF_WOUT = 985 * MiB,
                 OFF_WMEM = 987 * MiB, OFF_HM = 989 * MiB, OFF_MKV = 993 * MiB, OFF_LOGF = 997 * MiB, OFF_CB2 = 999 * MiB, OFF_LSE = 1001 * MiB, OFF_ROWSS = 1004 * MiB, OFF_WP = 1005 * MiB, WS_NEED = 1011 * MiB;
static_assert((size_t)NTOK * UP * 2 == 832 * MiB, "U size");
constexpr int LDS_BYTES = 147456;

struct Params {
    const float* x; const float* mem; const int* pos; const float* g_pre; const float* g_post; const float* g_mem; const float* w_in; const float* b_forget; const float* b_merge;
    const float* w_mem_kv; const float* w_a; const float* w_b; const float* w_m; const float* w_out; float* out; unsigned char* ws;
};

typedef float f32x2_mk __attribute__((ext_vector_type(2))); typedef __bf16 bf16x2_mk __attribute__((ext_vector_type(2)));
__device__ __forceinline__ unsigned pk_bf16(float lo, float hi) { f32x2_mk v = {lo, hi}; bf16x2_mk b = __builtin_convertvector(v, bf16x2_mk); return __builtin_bit_cast(unsigned, b); }
__device__ __forceinline__ float bf_lo(unsigned w) { return __uint_as_float(w << 16); }
__device__ __forceinline__ float bf_hi(unsigned w) { return __uint_as_float(w & 0xffff0000u); }
__device__ __forceinline__ float wave_sum(float v) {
#pragma unroll
    for (int o = 32; o >= 1; o >>= 1) v += __shfl_xor(v, o);
    return v;
}
__device__ __forceinline__ float silu_f(float v) { return v * __builtin_amdgcn_rcpf(1.0f + __builtin_amdgcn_exp2f(-v * LOG2E)); }
__device__ __forceinline__ float sigmoid_f(float v) { return __builtin_amdgcn_rcpf(1.0f + __builtin_amdgcn_exp2f(-v * LOG2E)); }
__device__ __forceinline__ void blk_sync_mem() {
    asm volatile("s_waitcnt vmcnt(0) lgkmcnt(0)" ::: "memory"); __syncthreads();
    if (threadIdx.x < 64) asm volatile("buffer_inv sc1\n\ts_waitcnt vmcnt(0)" ::: "memory");
    __syncthreads();
}

__device__ __forceinline__ int wt_colmap(int n0) {
    if (n0 < 4608) return n0;
    if (n0 < 6144) return n0 + 512;
    if (n0 < 6656) return n0 - 6144 + 7176;
    if (n0 < 7168) return n0 - 6656 + 4608;
    if (n0 < 7680) return n0 - 7168 + 6664;
    if (n0 < 8192) return n0 - 7680 + 7688;
    return n0 - 8192 + 8200;
}
__device__ __forceinline__ void tr_tile(LAS3 float* tile, const float* src, int lds_, int c0, int k0, bf16_t* dst, int ldd, int n0) {
    int tid = threadIdx.x; asm volatile("" : "+v"(tid));
#pragma unroll
    for (int i = 0; i < 2; ++i) { const int k = (tid >> 4) + 32 * i, n4 = (tid & 15) * 4;
        const f32x4 v = *(const f32x4*)(src + (size_t)(k0 + k) * lds_ + c0 + n4);
        tile[k * 65 + n4] = v[0]; tile[k * 65 + n4 + 1] = v[1]; tile[k * 65 + n4 + 2] = v[2]; tile[k * 65 + n4 + 3] = v[3]; }
    __syncthreads();
    { const int n = tid >> 3, kc = (tid & 7) * 8; u32x4 w;
      w.x = pk_bf16(tile[(kc + 0) * 65 + n], tile[(kc + 1) * 65 + n]); w.y = pk_bf16(tile[(kc + 2) * 65 + n], tile[(kc + 3) * 65 + n]);
      w.z = pk_bf16(tile[(kc + 4) * 65 + n], tile[(kc + 5) * 65 + n]); w.w = pk_bf16(tile[(kc + 6) * 65 + n], tile[(kc + 7) * 65 + n]);
      *(u32x4*)(dst + (size_t)(n0 + n) * ldd + k0 + kc) = w; }
    __syncthreads();
}
__device__ void phase0(const Params& p, LAS3 unsigned char* lds) {
    int tid = threadIdx.x; asm volatile("" : "+v"(tid)); const int lane = tid & 63, wid = tid >> 6, G = gridDim.x; int bid = blockIdx.x; asm volatile("" : "+s"(bid));
    size_t wz = 0; asm volatile("" : "+s"(wz)); unsigned char* ws = p.ws + wz;
    { LAS3 float* tile = (LAS3 float*)lds;
      for (int t = bid; t < 3712; t += G) {
          if (t < 2816) { const int nt = t >> 4, kt = t & 15; tr_tile(tile, p.w_in, IN_COLS, wt_colmap(nt * 64), kt * 64, (bf16_t*)(ws + OFF_WT), 1024, nt * 64); }
          else if (t < 3200) { const int q = t - 2816, w = q >> 7, r = q & 127, nt = r >> 3, kt = r & 7;
              const float* src = w == 0 ? p.w_a : (w == 1 ? p.w_b : p.w_m); tr_tile(tile, src, 1024, nt * 64, kt * 64, (bf16_t*)(ws + OFF_WA + (size_t)w * MiB), 512, nt * 64); }
          else if (t < 3456) { const int q = t - 3200, nt = q >> 4, kt = q & 15; tr_tile(tile, p.w_out, 1024, nt * 64, kt * 64, (bf16_t*)(ws + OFF_WOUT), 1024, nt * 64); }
          else { const int q = t - 3456, nt = q >> 4, kt = q & 15; tr_tile(tile, p.w_mem_kv, 1024, nt * 64, kt * 64, (bf16_t*)(ws + OFF_WMEM), 1024, nt * 64); }
      } }
    if (bid == 0) for (int i = tid; i < 4096 + 128; i += 512) ((unsigned*)(ws + OFF_ROWSS))[i] = 0u;
    __syncthreads();
    LAS3 float* wfb = (LAS3 float*)lds;
    for (int i = tid; i < 2048; i += 512) { const int k = i >> 1, hf = i & 1; const f32x4 v = *(const f32x4*)(p.w_in + (size_t)k * IN_COLS + 6656 + hf * 4); *(LAS3 f32x4*)(wfb + k * 8 + hf * 4) = v; }
    __syncthreads();
    bf16_t* H = (bf16_t*)(ws + OFF_H); float* LOGF = (float*)(ws + OFF_LOGF);
    f32x4 v[4];
    { const int r0 = bid * 8 + wid; if (r0 < NTOK) {
#pragma unroll
        for (int i = 0; i < 4; ++i) v[i] = *(const f32x4*)(p.x + (size_t)r0 * DM + 4 * lane + 256 * i); } }
    for (int row = bid * 8 + wid; row < NTOK; row += G * 8) {
        const int nrow = row + G * 8; f32x4 nv[4];
#pragma unroll
        for (int i = 0; i < 4; ++i) nv[i] = (f32x4){0.f, 0.f, 0.f, 0.f};
        if (nrow < NTOK) {
#pragma unroll
            for (int i = 0; i < 4; ++i) nv[i] = *(const f32x4*)(p.x + (size_t)nrow * DM + 4 * lane + 256 * i); }
        float ss = 0.f;
#pragma unroll
        for (int i = 0; i < 4; ++i) ss += v[i][0] * v[i][0] + v[i][1] * v[i][1] + v[i][2] * v[i][2] + v[i][3] * v[i][3];
        ss = wave_sum(ss); const float rstd = rsqrtf(ss * (1.0f / DM) + EPS);
        float fa[8];
#pragma unroll
        for (int e = 0; e < 8; ++e) fa[e] = 0.f;
#pragma unroll
        for (int i = 0; i < 4; ++i) { const int k = 4 * lane + 256 * i; const f32x4 g = *(const f32x4*)(p.g_pre + k); f32x4 y = v[i] * rstd * g;
            u32x2 w; w.x = pk_bf16(y[0], y[1]); w.y = pk_bf16(y[2], y[3]); *(u32x2*)(H + (size_t)row * DM + k) = w;
#pragma unroll
            for (int j = 0; j < 4; ++j) { const f32x4 w0 = *(const LAS3 f32x4*)(wfb + (k + j) * 8), w1 = *(const LAS3 f32x4*)(wfb + (k + j) * 8 + 4);
                fa[0] += y[j] * w0[0]; fa[1] += y[j] * w0[1]; fa[2] += y[j] * w0[2]; fa[3] += y[j] * w0[3]; fa[4] += y[j] * w1[0]; fa[5] += y[j] * w1[1]; fa[6] += y[j] * w1[2]; fa[7] += y[j] * w1[3]; } }
#pragma unroll
        for (int e = 0; e < 8; ++e) fa[e] = wave_sum(fa[e]);
        float mine = fa[0];
#pragma unroll
        for (int e = 1; e < 8; ++e) mine = (lane == e) ? fa[e] : mine;
        if (lane < 8) { const float z = mine + p.b_forget[lane]; const float lf = -(fmaxf(-z, 0.f) + log1pf(expf(-fabsf(z))));
            const int b = row / S, s = row % S; LOGF[(size_t)(b * 8 + lane) * S + s] = lf; }
#pragma unroll
        for (int i = 0; i < 4; ++i) v[i] = nv[i];
    }
    bf16_t* HM = (bf16_t*)(ws + OFF_HM);
    for (int row = bid * 8 + wid; row < NB * NMEM; row += G * 8) {
        const float* xr = p.mem + (size_t)row * DM; f32x4 v[4]; float ss = 0.f;
#pragma unroll
        for (int i = 0; i < 4; ++i) { v[i] = *(const f32x4*)(xr + 4 * lane + 256 * i); ss += v[i][0] * v[i][0] + v[i][1] * v[i][1] + v[i][2] * v[i][2] + v[i][3] * v[i][3]; }
        ss = wave_sum(ss); const float rstd = rsqrtf(ss * (1.0f / DM) + EPS);
#pragma unroll
        for (int i = 0; i < 4; ++i) { const int k = 4 * lane + 256 * i; const f32x4 g = *(const f32x4*)(p.g_mem + k); f32x4 y = v[i] * rstd * g;
            u32x2 w; w.x = pk_bf16(y[0], y[1]); w.y = pk_bf16(y[2], y[3]); *(u32x2*)(HM + (size_t)row * DM + k) = w; }
    }
    __syncthreads();
}

__device__ void scan_logf(const Params& p, LAS3 unsigned char* lds) {
    int tid = threadIdx.x; asm volatile("" : "+v"(tid)); const int lane = tid & 63, wid = tid >> 6;
    size_t wz = 0; asm volatile("" : "+s"(wz)); unsigned char* ws = p.ws + wz;
    const float* LOGF = (const float*)(ws + OFF_LOGF); float* CB2 = (float*)(ws + OFF_CB2);
    LAS3 float* wt = (LAS3 float*)lds;
    for (int bh = (int)blockIdx.x - 32 + ((int)blockIdx.x < 32 ? (int)gridDim.x : 0); bh < 64; bh += gridDim.x) {
        const float* src = LOGF + (size_t)bh * S + tid * 16; f32x4 v[4];
#pragma unroll
        for (int i = 0; i < 4; ++i) v[i] = *(const f32x4*)(src + 4 * i);
        float run = 0.f;
#pragma unroll
        for (int i = 0; i < 4; ++i)
#pragma unroll
            for (int j = 0; j < 4; ++j) { run += v[i][j]; v[i][j] = run; }
        float inc = run;
#pragma unroll
        for (int o = 1; o < 64; o <<= 1) { const float t = __shfl_up(inc, o); if (lane >= o) inc += t; }
        if (lane == 63) wt[wid] = inc;
        __syncthreads();
        float base = inc - run;
        for (int w = 0; w < wid; ++w) base += wt[w];
        float* dst = CB2 + (size_t)bh * S + tid * 16;
#pragma unroll
        for (int i = 0; i < 4; ++i) { f32x4 o = (v[i] + base) * (-LOG2E); *(f32x4*)(dst + 4 * i) = o; }
        __syncthreads();
    }
}
using pg8::Unit;
struct EpiP1 {
    static constexpr bool PERM = true, AFTER_DRAIN = false;
    bf16_t* O; int ldc; const int* pos; int mode; unsigned* nrm;
    __device__ __forceinline__ void operator()(f32x4 (&acc)[2][2][4][2], const Unit& u, int wr, int wc, int fr, int fq, int lane) const {
        const int row0 = u.pm * 256 + wr * 64 + fr, colb = u.pn * 256 + wc * 32 + 8 * fq;
        float sc = 1.f; bool rope = false;
        if (mode == 0) { if (u.pn < 6 || u.pn >= 24) sc = SC128; else if (u.pn == 18 || u.pn == 19) sc = SC64; rope = (u.pn < 12) && (wc == 0); }
        if (rope) {
            const float sgn = fq < 2 ? -1.f : 1.f; float inv[8];
#pragma unroll
            for (int e = 0; e < 8; ++e) inv[e] = __builtin_amdgcn_exp2f(-(float)(8 * (fq & 1) + e) * (18.931568569324174f / 16.0f)) * 0.15915494309189535f;
#pragma unroll
            for (int ai = 0; ai < 2; ++ai)
#pragma unroll
                for (int m = 0; m < 4; ++m) { const float pp = (float)pos[row0 + ai * 128 + m * 16];
#pragma unroll
                    for (int n = 0; n < 2; ++n)
#pragma unroll
                        for (int j = 0; j < 4; ++j) { const float fr_ = __builtin_amdgcn_fractf(pp * inv[4 * n + j]);
                            const float sn = __builtin_amdgcn_sinf(fr_) * sgn, cs = __builtin_amdgcn_cosf(fr_);
#pragma unroll
                            for (int bj = 0; bj < 2; ++bj) { const float v = acc[ai][bj][m][n][j]; const float pv = __shfl_xor(v, 32); acc[ai][bj][m][n][j] = v * cs + pv * sn; } }
                    __builtin_amdgcn_sched_barrier(0); }
        }
        if (mode == 0 && u.pn >= 18 && u.pn <= 21) {
            const int kind = u.pn >= 20 ? 1 : 0, bb = (u.pm * 256) >> 13;
#pragma unroll
            for (int bj = 0; bj < 2; ++bj) { float mxs = 0.f;
#pragma unroll
                for (int ai = 0; ai < 2; ++ai)
#pragma unroll
                    for (int m = 0; m < 4; ++m) { const f32x4 a0 = acc[ai][bj][m][0], a1 = acc[ai][bj][m][1];
                        float ss = (a0[0] * a0[0] + a0[1] * a0[1]) + (a0[2] * a0[2] + a0[3] * a0[3]) + (a1[0] * a1[0] + a1[1] * a1[1]) + (a1[2] * a1[2] + a1[3] * a1[3]);
                        ss += __shfl_xor(ss, 16); ss += __shfl_xor(ss, 32); mxs = fmaxf(mxs, ss); }
                mxs = fmaxf(mxs, __shfl_xor(mxs, 1)); mxs = fmaxf(mxs, __shfl_xor(mxs, 2)); mxs = fmaxf(mxs, __shfl_xor(mxs, 4)); mxs = fmaxf(mxs, __shfl_xor(mxs, 8));
                const int hd = (u.pn & 1) * 4 + 2 * bj + (wc >> 1);
                if (lane == 0) atomicMax(nrm + (kind ? 4096 + ((bb * 8 + hd) * 2 + (wc & 1)) : (((bb * 8 + hd) * 32 + (u.pm & 31)) * 2 + (wc & 1))), __float_as_uint(mxs * sc * sc)); }
            __builtin_amdgcn_sched_barrier(0);
        }
#pragma unroll
        for (int ai = 0; ai < 2; ++ai)
#pragma unroll
            for (int m = 0; m < 4; ++m) { bf16_t* rowp = O + (size_t)(row0 + ai * 128 + m * 16) * ldc + colb;
#pragma unroll
                for (int bj = 0; bj < 2; ++bj) { const f32x4 v0 = acc[ai][bj][m][0] * sc, v1 = acc[ai][bj][m][1] * sc; u32x4 w;
                    w.x = pk_bf16(v0[0], v0[1]); w.y = pk_bf16(v0[2], v0[3]); w.z = pk_bf16(v1[0], v1[1]); w.w = pk_bf16(v1[2], v1[3]); *(u32x4*)(rowp + bj * 128) = w; } }
    }
};
__device__ __forceinline__ void unpack8(const u32x4 w, float (&f)[8]) { f[0] = bf_lo(w.x); f[1] = bf_hi(w.x); f[2] = bf_lo(w.y); f[3] = bf_hi(w.y); f[4] = bf_lo(w.z); f[5] = bf_hi(w.z); f[6] = bf_lo(w.w); f[7] = bf_hi(w.w); }
__device__ __forceinline__ u32x4 pack8(const float (&f)[8]) { u32x4 w; w.x = pk_bf16(f[0], f[1]); w.y = pk_bf16(f[2], f[3]); w.z = pk_bf16(f[4], f[5]); w.w = pk_bf16(f[6], f[7]); return w; }
struct EpiZ {
    static constexpr bool PERM = true, AFTER_DRAIN = false;
    bf16_t* U; const float* lse; int row_base;
    __device__ __forceinline__ void operator()(f32x4 (&acc)[2][2][4][2], const Unit& u, int wr, int wc, int fr, int fq, int lane) const {
        const int zt = u.pn >> 1;
#pragma unroll
        for (int ai = 0; ai < 2; ++ai)
#pragma unroll
            for (int m = 0; m < 4; ++m) { const unsigned row = ai * 128 + wr * 64 + m * 16 + fr;
#pragma unroll
                for (int bj = 0; bj < 2; ++bj) { const int cbr = (u.pn & 1) * 256 + bj * 128 + wc * 32 + 8 * fq;
                    float w0 = 1.f, w1 = 0.f, w2 = 0.f;
                    if (zt == 0) { const int head = cbr >> 7; const float l0 = lse[row * 12 + head], l1 = lse[row * 12 + 4 + head], l2 = lse[row * 12 + 8 + head];
                        const float mx = fmaxf(l0, fmaxf(l1, l2)); w0 = __builtin_amdgcn_exp2f(l0 - mx); w1 = __builtin_amdgcn_exp2f(l1 - mx); w2 = __builtin_amdgcn_exp2f(l2 - mx);
                        const float rs = __builtin_amdgcn_rcpf(w0 + w1 + w2); w0 *= rs; w1 *= rs; w2 *= rs; }
                    bf16_t* ptr = U + (row * (unsigned)UP + (unsigned)((zt == 0 ? 0 : (zt == 1 ? C_QB : C_QM)) + cbr));
                    { float v[8]; unpack8(*(const u32x4*)ptr, v);
                      if (zt == 0) { float v1[8], v2[8]; unpack8(*(const u32x4*)(ptr + 512), v1); unpack8(*(const u32x4*)(ptr + 1024), v2);
#pragma unroll
                          for (int e = 0; e < 8; ++e) v[e] = w0 * v[e] + w1 * v1[e] + w2 * v2[e]; }
#pragma unroll
                      for (int j = 0; j < 4; ++j) { v[j] *= silu_f(acc[ai][bj][m][0][j]); v[4 + j] *= silu_f(acc[ai][bj][m][1][j]); }
                      *(u32x4*)ptr = pack8(v); }
                    __builtin_amdgcn_sched_barrier(0); } }
    }
};
struct EpiG {
    static constexpr bool PERM = true, AFTER_DRAIN = false;
    bf16_t* Gt; const float* bias; int ld;
    __device__ __forceinline__ void operator()(f32x4 (&acc)[2][2][4][2], const Unit& u, int wr, int wc, int fr, int fq, int lane) const {
#pragma unroll
        for (int bj = 0; bj < 2; ++bj) { const int c8 = u.pn * 256 + bj * 128 + wc * 32 + 8 * fq; const f32x4 b0 = *(const f32x4*)(bias + c8), b1 = *(const f32x4*)(bias + c8 + 4);
#pragma unroll
            for (int ai = 0; ai < 2; ++ai)
#pragma unroll
                for (int m = 0; m < 4; ++m) { const int rl = ai * 128 + wr * 64 + m * 16 + fr; float z[8];
#pragma unroll
                    for (int j = 0; j < 4; ++j) { z[j] = sigmoid_f(acc[ai][bj][m][0][j] + b0[j]); z[4 + j] = sigmoid_f(acc[ai][bj][m][1][j] + b1[j]); }
                    *(u32x4*)(Gt + ((unsigned)rl * (unsigned)ld + (unsigned)c8)) = pack8(z); } }
    }
};
struct EpiBr {
    static constexpr bool PERM = true, AFTER_DRAIN = false;
    bf16_t* Mg; const bf16_t* Gt; int first; int jj; int ld; int ldg;
    __device__ __forceinline__ void operator()(f32x4 (&acc)[2][2][4][2], const Unit& u, int wr, int wc, int fr, int fq, int lane) const {
#pragma unroll
        for (int ai = 0; ai < 2; ++ai)
#pragma unroll
            for (int m = 0; m < 4; ++m) { const int rl = ai * 128 + wr * 64 + m * 16 + fr;
#pragma unroll
                for (int bj = 0; bj < 2; ++bj) { const int c8 = u.pn * 256 + bj * 128 + wc * 32 + 8 * fq; const unsigned off = (unsigned)rl * (unsigned)ld + (unsigned)c8;
                    float g[8], z[8]; unpack8(*(const u32x4*)(Gt + ((unsigned)rl * (unsigned)ldg + (unsigned)c8)), g);
#pragma unroll
                    for (int j = 0; j < 4; ++j) { z[j] = acc[ai][bj][m][0][j] * g[j]; z[4 + j] = acc[ai][bj][m][1][j] * g[4 + j]; }
#ifdef DBG_ZERO_BR
                    if (jj == DBG_ZERO_BR) { for (int j = 0; j < 8; ++j) z[j] = 0.f; }
#endif
                    if (!first) { float o[8]; unpack8(*(const u32x4*)(Mg + off), o);
#pragma unroll
                        for (int j = 0; j < 8; ++j) z[j] += o[j]; }
                    *(u32x4*)(Mg + off) = pack8(z); } }
    }
};
struct EpiOut {
    static constexpr bool PERM = true, AFTER_DRAIN = false;
    bf16_t* U; LAS3 float* ssp; int row_base;
    __device__ __forceinline__ void operator()(f32x4 (&acc)[2][2][4][2], const Unit& u, int wr, int wc, int fr, int fq, int lane) const {
#pragma unroll
        for (int ai = 0; ai < 2; ++ai)
#pragma unroll
            for (int m = 0; m < 4; ++m) { const unsigned row = ai * 128 + wr * 64 + m * 16 + fr; float ss = 0.f;
#pragma unroll
                for (int bj = 0; bj < 2; ++bj) { const int c8 = u.pn * 256 + bj * 128 + wc * 32 + 8 * fq; float z[8];
#pragma unroll
                    for (int j = 0; j < 4; ++j) { z[j] = acc[ai][bj][m][0][j]; z[4 + j] = acc[ai][bj][m][1][j]; }
#pragma unroll
                    for (int j = 0; j < 8; ++j) ss += z[j] * z[j];
                    *(u32x4*)(U + (row * (unsigned)UP + (unsigned)(C_OUT + c8))) = pack8(z); }
                ss += __shfl_xor(ss, 16); ss += __shfl_xor(ss, 32);
                if (fq == 0) ssp[row * 16 + u.pn * 4 + wc] = ss;
                __builtin_amdgcn_sched_barrier(0); }
    }
};
struct EpiZG {
    static constexpr bool PERM = true, AFTER_DRAIN = false;
    EpiZ z; EpiG g;
    __device__ __forceinline__ void operator()(f32x4 (&acc)[2][2][4][2], const Unit& u, int wr, int wc, int fr, int fq, int lane) const {
        if (u.pn < 6) z(acc, u, wr, wc, fr, fq, lane);
        else { Unit u2; u2.pm = u.pm; u2.pn = u.pn - 6; g(acc, u2, wr, wc, fr, fq, lane); }
    }
};
struct PanelOrder {
    int pm_a, n0, cnt;
    __device__ __forceinline__ bool next(int i, Unit& u) const { if (i >= cnt) return false; u.pm = pm_a; u.pn = n0 + i; return true; }
    __device__ __forceinline__ void a_ready(const Unit&) const {}
    __device__ __forceinline__ void done(const Unit&) const {}
};

namespace at128 {
constexpr int KROW = 272, VROW = 288, LDS_K = 0, LDS_V = 256 * KROW, LDS_TOTAL = LDS_V + 256 * VROW;
typedef short v4i16_t __attribute__((ext_vector_type(4)));
struct UArgs { bf16_t* Qp; long q_rs; const bf16_t* Kp; const bf16_t* Vp; long k_rs; int klo; float* lsep; long lse_rs; };
__device__ __forceinline__ void issue_band(const UArgs& a, int tid, u32x4 (&kreg)[8], u32x4 (&vreg)[8]) {
#pragma unroll
    for (int i = 0; i < 8; ++i) { const int c = tid + 512 * i, row = c >> 4, ch = c & 15; kreg[i] = (u32x4){0u, 0u, 0u, 0u}; vreg[i] = (u32x4){0u, 0u, 0u, 0u};
        if (row >= a.klo) { kreg[i] = *(const u32x4*)(a.Kp + (long)row * a.k_rs + ch * 8); vreg[i] = *(const u32x4*)(a.Vp + (long)row * a.k_rs + ch * 8); } }
}
template <bool BAND>
__device__ __forceinline__ void unit(LAS3 unsigned char* lds, const UArgs& cur, u32x4 (&kreg)[8], u32x4 (&vreg)[8], bool has_next, const UArgs& nxt) {
    bf16_t* Qp = cur.Qp; const long q_rs = cur.q_rs; const int klo = cur.klo; float* lsep = cur.lsep; const long lse_rs = cur.lse_rs;
    int tid = threadIdx.x; asm volatile("" : "+v"(tid));
    const int lane = tid & 63, w = __builtin_amdgcn_readfirstlane(tid >> 6), qi = lane & 15, g = lane >> 4;
#pragma unroll
    for (int i = 0; i < 8; ++i) { const int c = tid + 512 * i, row = c >> 4, ch = c & 15;
        *(LAS3 u32x4*)(lds + LDS_K + row * KROW + ch * 16) = kreg[i]; *(LAS3 u32x4*)(lds + LDS_V + row * VROW + ch * 16) = vreg[i]; }
    const int qrow = 16 * w + qi; bf16_t* qptr = Qp + (long)qrow * q_rs;
    bf16x8 qf[4];
#pragma unroll
    for (int s = 0; s < 4; ++s) qf[s] = *(const bf16x8*)(qptr + 32 * s + 8 * g);
    __syncthreads();
    if (has_next) issue_band(nxt, tid, kreg, vreg);
    constexpr int NT = BAND ? 10 : 16; const int jb = BAND ? w : 0;
    f32x4 st[NT];
#pragma unroll
    for (int jt = 0; jt < NT; ++jt) {
        if (BAND && jt == 9) { st[jt] = (f32x4){-1e30f, -1e30f, -1e30f, -1e30f}; continue; }
        const int j = jb + jt; f32x4 a = (f32x4){0.f, 0.f, 0.f, 0.f};
        const LAS3 unsigned char* kp = lds + LDS_K + (16 * j + qi) * KROW + 16 * g;
#pragma unroll
        for (int s = 0; s < 4; ++s) { const bf16x8 kf = *(const LAS3 bf16x8*)(kp + 64 * s); a = __builtin_amdgcn_mfma_f32_16x16x32_bf16(kf, qf[s], a, 0, 0, 0); }
        if (BAND) { const int qidx = 16 * w + qi;
#pragma unroll
            for (int i = 0; i < 4; ++i) { const int ki = 16 * j + 4 * g + i; const bool ok = (ki >= qidx) && (ki <= qidx + 128) && (ki >= klo); a[i] = ok ? a[i] : -1e30f; } }
        st[jt] = a;
    }
    float mx = -1e30f;
#pragma unroll
    for (int jt = 0; jt < NT; ++jt) mx = fmaxf(mx, fmaxf(fmaxf(st[jt][0], st[jt][1]), fmaxf(st[jt][2], st[jt][3])));
    mx = fmaxf(mx, __shfl_xor(mx, 16)); mx = fmaxf(mx, __shfl_xor(mx, 32));
    float sum = 0.f;
#pragma unroll
    for (int jt = 0; jt < NT; ++jt) {
#pragma unroll
        for (int i = 0; i < 4; ++i) { const float e = __builtin_amdgcn_exp2f(st[jt][i] - mx); st[jt][i] = e; sum += e; } }
    sum += __shfl_xor(sum, 16); sum += __shfl_xor(sum, 32);
    f32x4 o[8];
#pragma unroll
    for (int c = 0; c < 8; ++c) o[c] = (f32x4){0.f, 0.f, 0.f, 0.f};
#pragma unroll
    for (int pp = 0; pp < NT / 2; ++pp) {
        int j0 = jb + 2 * pp, j1 = j0 + 1; if (j1 > 15) j1 = 15;
        u32x4 pw; pw.x = pk_bf16(st[2 * pp][0], st[2 * pp][1]); pw.y = pk_bf16(st[2 * pp][2], st[2 * pp][3]); pw.z = pk_bf16(st[2 * pp + 1][0], st[2 * pp + 1][1]); pw.w = pk_bf16(st[2 * pp + 1][2], st[2 * pp + 1][3]);
        const bf16x8 pf = __builtin_bit_cast(bf16x8, pw);
        const int q4 = qi >> 2, p4 = qi & 3;
        const LAS3 unsigned char* v0 = lds + LDS_V + (16 * j0 + 4 * g + q4) * VROW + 8 * p4;
        const LAS3 unsigned char* v1 = lds + LDS_V + (16 * j1 + 4 * g + q4) * VROW + 8 * p4;
#pragma unroll
        for (int c = 0; c < 8; ++c) {
            const v4i16_t lo = __builtin_amdgcn_ds_read_tr16_b64_v4i16((LAS3 v4i16_t*)(v0 + 32 * c));
            const v4i16_t hi = __builtin_amdgcn_ds_read_tr16_b64_v4i16((LAS3 v4i16_t*)(v1 + 32 * c));
            const bf16x8 vf = (bf16x8){lo[0], lo[1], lo[2], lo[3], hi[0], hi[1], hi[2], hi[3]};
            o[c] = __builtin_amdgcn_mfma_f32_16x16x32_bf16(vf, pf, o[c], 0, 0, 0);
        }
    }
    const float rinv = __builtin_amdgcn_rcpf(sum);
#pragma unroll
    for (int c = 0; c < 8; ++c) { const f32x4 v = o[c] * rinv; u32x2 wv; wv.x = pk_bf16(v[0], v[1]); wv.y = pk_bf16(v[2], v[3]); *(u32x2*)(qptr + 16 * c + 4 * g) = wv; }
    if (lsep && g == 0) lsep[(long)qrow * lse_rs] = mx + __builtin_amdgcn_logf(sum);
    __syncthreads();
}

template <bool BAND>
__device__ void unit_naive(bf16_t* Qp, long q_rs, const bf16_t* Kp, const bf16_t* Vp, long k_rs, int klo, float* lsep, long lse_rs) {
    int tid = threadIdx.x; asm volatile("" : "+v"(tid)); const int lane = tid & 63, w = tid >> 6;
    for (int qrow = w; qrow < 128; qrow += 8) {
        bf16_t* qptr = Qp + (long)qrow * q_rs; float lg[4]; int kidx[4]; bool ok[4];
#pragma unroll
        for (int i = 0; i < 4; ++i) { const int n = lane + 64 * i; kidx[i] = BAND ? qrow + n : n; ok[i] = BAND ? (n <= 128 && kidx[i] >= klo) : true;
            float a = 0.f;
            if (ok[i]) { const bf16_t* kp = Kp + (long)kidx[i] * k_rs;
                for (int c = 0; c < 16; ++c) { const u32x4 qa = *(const u32x4*)(qptr + 8 * c), ka = *(const u32x4*)(kp + 8 * c);
                    a += bf_lo(qa.x) * bf_lo(ka.x) + bf_hi(qa.x) * bf_hi(ka.x) + bf_lo(qa.y) * bf_lo(ka.y) + bf_hi(qa.y) * bf_hi(ka.y) + bf_lo(qa.z) * bf_lo(ka.z) + bf_hi(qa.z) * bf_hi(ka.z) + bf_lo(qa.w) * bf_lo(ka.w) + bf_hi(qa.w) * bf_hi(ka.w); } }
            lg[i] = ok[i] ? a : -1e30f; }
        float mx = fmaxf(fmaxf(lg[0], lg[1]), fmaxf(lg[2], lg[3]));
#pragma unroll
        for (int of = 32; of >= 1; of >>= 1) mx = fmaxf(mx, __shfl_xor(mx, of));
        float sum = 0.f;
#pragma unroll
        for (int i = 0; i < 4; ++i) { lg[i] = ok[i] ? __builtin_amdgcn_exp2f(lg[i] - mx) : 0.f; sum += lg[i]; }
        sum = wave_sum(sum);
        float o0 = 0.f, o1 = 0.f; const int nk = BAND ? 129 : 256;
        for (int n = 0; n < nk; ++n) { const int i = n >> 6; const float pv = __shfl(i == 0 ? lg[0] : (i == 1 ? lg[1] : (i == 2 ? lg[2] : lg[3])), n & 63);
            const int ki = BAND ? qrow + n : n; if (BAND && ki < klo) continue;
            const unsigned vv = *(const unsigned*)(Vp + (long)ki * k_rs + 2 * lane); o0 += pv * bf_lo(vv); o1 += pv * bf_hi(vv); }
        const float ri = 1.0f / sum;
        *(unsigned*)(qptr + 2 * lane) = pk_bf16(o0 * ri, o1 * ri);
        if (lsep && lane == 0) lsep[(long)qrow * lse_rs] = mx + __builtin_amdgcn_logf(sum);
    }
}
}

__device__ void fox_naive(bf16_t* U, const float* CB2) {
    int tid = threadIdx.x; asm volatile("" : "+v"(tid)); const int lane = tid & 63, wid = tid >> 6;
    for (long qi = (long)blockIdx.x * 8 + wid; qi < (long)NTOK * 8; qi += (long)gridDim.x * 8) {
        const int h = (int)(qi & 7); const long row = qi >> 3; const int b = (int)(row / S), t = (int)(row % S);
        const bf16_t* qp = U + row * UP + C_QB + h * 64; const float* cb = CB2 + (size_t)(b * 8 + h) * S;
        float q[64];
#pragma unroll
        for (int c = 0; c < 8; ++c) { const u32x4 w = *(const u32x4*)(qp + 8 * c); q[8*c] = bf_lo(w.x); q[8*c+1] = bf_hi(w.x); q[8*c+2] = bf_lo(w.y); q[8*c+3] = bf_hi(w.y); q[8*c+4] = bf_lo(w.z); q[8*c+5] = bf_hi(w.z); q[8*c+6] = bf_lo(w.w); q[8*c+7] = bf_hi(w.w); }
        float m = -1e30f, l = 0.f; float o[64];
#pragma unroll
        for (int d = 0; d < 64; ++d) o[d] = 0.f;
        for (int s0 = lane; s0 <= t; s0 += 64) {
            const bf16_t* kp = U + ((long)b * S + s0) * UP + C_KB + h * 64; const bf16_t* vp = U + ((long)b * S + s0) * UP + C_VB + h * 64;
            float x = 0.f;
#pragma unroll
            for (int c = 0; c < 8; ++c) { const u32x4 w = *(const u32x4*)(kp + 8 * c);
                x += q[8*c] * bf_lo(w.x) + q[8*c+1] * bf_hi(w.x) + q[8*c+2] * bf_lo(w.y) + q[8*c+3] * bf_hi(w.y) + q[8*c+4] * bf_lo(w.z) + q[8*c+5] * bf_hi(w.z) + q[8*c+6] * bf_lo(w.w) + q[8*c+7] * bf_hi(w.w); }
            x += cb[s0];
            const float mn = fmaxf(m, x), f = __builtin_amdgcn_exp2f(m - mn), pz = __builtin_amdgcn_exp2f(x - mn); m = mn; l = l * f + pz;
#pragma unroll
            for (int c = 0; c < 8; ++c) { const u32x4 w = *(const u32x4*)(vp + 8 * c);
                o[8*c] = o[8*c] * f + pz * bf_lo(w.x); o[8*c+1] = o[8*c+1] * f + pz * bf_hi(w.x); o[8*c+2] = o[8*c+2] * f + pz * bf_lo(w.y); o[8*c+3] = o[8*c+3] * f + pz * bf_hi(w.y);
                o[8*c+4] = o[8*c+4] * f + pz * bf_lo(w.z); o[8*c+5] = o[8*c+5] * f + pz * bf_hi(w.z); o[8*c+6] = o[8*c+6] * f + pz * bf_lo(w.w); o[8*c+7] = o[8*c+7] * f + pz * bf_hi(w.w); }
        }
        float mg = m;
#pragma unroll
        for (int of = 32; of >= 1; of >>= 1) mg = fmaxf(mg, __shfl_xor(mg, of));
        const float sc = __builtin_amdgcn_exp2f(m - mg); l = wave_sum(l * sc); const float rl = 1.0f / l;
        float mine0 = 0.f;
#pragma unroll
        for (int d = 0; d < 64; ++d) { const float v = wave_sum(o[d] * sc) * rl; mine0 = (lane == d) ? v : mine0; }
        const float nb = __shfl_xor(mine0, 1);
        if ((lane & 1) == 0) *(unsigned*)((bf16_t*)qp + lane) = pk_bf16(mine0, nb);
    }
}
__device__ void phase1(const Params& p, LAS3 unsigned char* lds) {
    size_t wz = 0; asm volatile("" : "+s"(wz)); unsigned char* ws = p.ws + wz;
    scan_logf(p, lds);
    { pg8::Gemm g{(const bf16_t*)(ws + OFF_H), (const bf16_t*)(ws + OFF_WT), NTOK, UP, DM, DM}; pg8::StaticOrder S; S.init(NTOK, UP, (int)gridDim.x, (int)blockIdx.x);
      EpiP1 E{(bf16_t*)(ws + OFF_U), UP, p.pos, 0, (unsigned*)(ws + OFF_ROWSS)};
      pg8::gemm_phase<EpiP1, pg8::StaticOrder, true, true>(lds, g, S, E); }
#ifdef MKV_NAIVE
    { int tid = threadIdx.x; asm volatile("" : "+v"(tid)); const bf16_t* HM = (const bf16_t*)(ws + OFF_HM); bf16_t* MKV = (bf16_t*)(ws + OFF_MKV);
      for (int e = blockIdx.x * 512 + tid; e < NB * NMEM * 1024; e += gridDim.x * 512) { const int row = e >> 10, col = e & 1023; float a = 0.f;
          for (int k = 0; k < 1024; ++k) a += __uint_as_float((unsigned)HM[(size_t)row * 1024 + k] << 16) * p.w_mem_kv[(size_t)k * 1024 + col];
          MKV[e] = (bf16_t)(pk_bf16(a, 0.f) & 0xffffu); } }
#else
    { pg8::Gemm g{(const bf16_t*)(ws + OFF_HM), (const bf16_t*)(ws + OFF_WMEM), NB * NMEM, 1024, DM, DM}; pg8::StaticOrder S; S.init(NB * NMEM, 1024, (int)gridDim.x, (int)blockIdx.x);
      EpiP1 E{(bf16_t*)(ws + OFF_MKV), 1024, p.pos, 1, (unsigned*)(ws + OFF_ROWSS)};
      pg8::gemm_phase<EpiP1, pg8::StaticOrder, true, true>(lds, g, S, E); }
#endif
}
#ifdef A_NAIVE
#define AT_UNIT_A(...) at128::unit_naive<true>(__VA_ARGS__)
#else
#define AT_UNIT_A(...) at128::unit<true>(lds, __VA_ARGS__)
#endif
#ifdef M_NAIVE
#define AT_UNIT_M(...) at128::unit_naive<false>(__VA_ARGS__)
#else
#define AT_UNIT_M(...) at128::unit<false>(lds, __VA_ARGS__)
#endif
__device__ void phase2(const Params& p, LAS3 unsigned char* lds) {
    size_t wz = 0; asm volatile("" : "+s"(wz)); unsigned char* ws = p.ws + wz;   bf16_t* U = (bf16_t*)(ws + OFF_U);
#ifdef FOX_NAIVE
    fox_naive(U, (const float*)(ws + OFF_CB2));
#elif !defined(NO_FOX)
    { const attn_body::AttnTensors AT{(const attn_body::bf16*)(U + C_QB), (const attn_body::bf16*)(U + C_KB), (const attn_body::bf16*)(U + C_VB), (attn_body::bf16*)(U + C_QB), (const float*)(ws + OFF_CB2), (const float*)(ws + OFF_ROWSS)};
      const attn_body::StaticOrder SO((int)gridDim.x, (int)blockIdx.x);
      attn_body::attn_phase<attn_body::StaticOrder>((char*)lds, AT, SO); }
#endif
    __syncthreads();
#ifndef NO_AT128
    float* LSE = (float*)(ws + OFF_LSE);
    {
      auto decA = [&](int a0) { const int a = (a0 & 7) * 768 + (a0 >> 3);     const int b = a / 768, rem = a % 768, hh = rem >> 6, blk = rem & 63, grp = hh >> 2, dil = 1 << (2 * grp), nb = 64 >> (2 * grp), r = blk / nb, n = blk % nb;
          const long qrow0 = (long)b * S + (long)(128 * n) * dil + r, krow0 = qrow0 - 128L * dil;
          return at128::UArgs{U + qrow0 * UP + C_QA + hh * 128, (long)dil * UP, U + krow0 * UP + C_KA + hh * 128, U + krow0 * UP + C_VA + hh * 128, (long)dil * UP, n == 0 ? 128 : 0, LSE + qrow0 * 12 + hh, (long)dil * 12}; };
      u32x4 kreg[8], vreg[8]; int tid0 = threadIdx.x; asm volatile("" : "+v"(tid0)); int a = blockIdx.x;
      if (a < 6144) { at128::UArgs cur = decA(a); at128::issue_band(cur, tid0, kreg, vreg);
          for (; a < 6144; a += gridDim.x) { const int an = a + gridDim.x; const bool has = an < 6144; const at128::UArgs nxt = decA(has ? an : a);
              at128::unit<true>(lds, cur, kreg, vreg, has, nxt); cur = nxt; } } }
    const bf16_t* MKV = (const bf16_t*)(ws + OFF_MKV);
    { auto decM = [&](int a0) { const int a = (a0 & 7) * 256 + (a0 >> 3);     const int b = a >> 8, rem = a & 255, h = rem >> 6, n = rem & 63; const long qrow0 = (long)b * S + 128 * n;
          return at128::UArgs{U + qrow0 * UP + C_QM + h * 128, (long)UP, MKV + (long)b * NMEM * 1024 + h * 128, MKV + (long)b * NMEM * 1024 + 512 + h * 128, 1024L, 0, nullptr, 0}; };
      u32x4 kreg[8], vreg[8]; int tid0 = threadIdx.x; asm volatile("" : "+v"(tid0)); int a = blockIdx.x;
      if (a < 2048) { at128::UArgs cur = decM(a); at128::issue_band(cur, tid0, kreg, vreg);
          for (; a < 2048; a += gridDim.x) { const int an = a + gridDim.x; const bool has = an < 2048; const at128::UArgs nxt = decM(has ? an : a);
              at128::unit<false>(lds, cur, kreg, vreg, has, nxt); cur = nxt; } } }
#endif
}
__device__ void phase3(const Params& p, LAS3 unsigned char* lds) {
    size_t wz = 0; asm volatile("" : "+s"(wz)); unsigned char* ws = p.ws + wz;   bf16_t* U = (bf16_t*)(ws + OFF_U); const bf16_t* H = (const bf16_t*)(ws + OFF_H); const bf16_t* WT = (const bf16_t*)(ws + OFF_WT);
    for (int pm = blockIdx.x; pm < NTOK / 256; pm += gridDim.x) {
        bf16_t* Mg = (bf16_t*)((unsigned char*)p.out + (size_t)pm * MiB); bf16_t* Gt = Mg + 256 * 1024; constexpr int TP = 1024;
#ifdef DBG_GT0
        Gt = U + (size_t)pm * 256 * UP;
#endif
        bf16_t* Gall = U + (size_t)pm * 256 * UP + C_KA;
        { pg8::Gemm g{H, WT + (size_t)6656 * 1024, NTOK, 4608, DM, DM}; PanelOrder S{pm, 0, 18};
          EpiZG E{EpiZ{U + (size_t)pm * 256 * UP, (const float*)(ws + OFF_LSE) + (size_t)pm * 256 * 12, pm * 256}, EpiG{Gall, p.b_merge, UP}};
          pg8::gemm_phase<EpiZG, PanelOrder, true, true>(lds, g, S, E); }
        blk_sync_mem();
#if defined(DBG_STAGE) && DBG_STAGE == 1
        { int t4 = threadIdx.x; const int lane = t4 & 63, wid = t4 >> 6;
          for (int rl = wid; rl < 256; rl += 8) { const size_t row = (size_t)pm * 256 + rl;
              for (int i = 0; i < 4; ++i) { const int k = 4 * lane + 256 * i; const u32x2 w = *(const u32x2*)(U + row * UP + DBG_COL + k); const f32x4 xv = *(const f32x4*)(p.x + row * DM + k);
                  f32x4 o; o[0] = xv[0] + bf_lo(w.x); o[1] = xv[1] + bf_hi(w.x); o[2] = xv[2] + bf_lo(w.y); o[3] = xv[3] + bf_hi(w.y); *(f32x4*)(p.out + row * DM + k) = o; } }
          continue; }
#endif
#ifdef P3_NAIVE
        {
          int t4 = threadIdx.x; asm volatile("" : "+v"(t4)); const int c0 = 2 * t4; LAS3 float* mrg = (LAS3 float*)lds; LAS3 float* red = mrg + 4 * 1024;
          for (int r0 = 0; r0 < 256; r0 += 4) {
              float mg[4][2];
              for (int r = 0; r < 4; ++r) { mg[r][0] = 0.f; mg[r][1] = 0.f; }
              for (int j = 0; j < 3; ++j) {
                  float ga[4][2], br[4][2];
                  for (int r = 0; r < 4; ++r) { ga[r][0] = ga[r][1] = br[r][0] = br[r][1] = 0.f; }
                  for (int k = 0; k < 1024; ++k) { const float w0 = p.w_in[(size_t)k * IN_COLS + 8200 + j * 1024 + c0], w1 = p.w_in[(size_t)k * IN_COLS + 8200 + j * 1024 + c0 + 1];
#pragma unroll
                      for (int r = 0; r < 4; ++r) { const float hv = __uint_as_float((unsigned)H[((size_t)pm * 256 + r0 + r) * 1024 + k] << 16); ga[r][0] += hv * w0; ga[r][1] += hv * w1; } }
                  const float* wj = j == 0 ? p.w_a : (j == 1 ? p.w_b : p.w_m); const int yc = j == 0 ? C_QA : (j == 1 ? C_QB : C_QM);
                  for (int k = 0; k < 512; ++k) { const float w0 = wj[(size_t)k * 1024 + c0], w1 = wj[(size_t)k * 1024 + c0 + 1];
#pragma unroll
                      for (int r = 0; r < 4; ++r) { const float yv = __uint_as_float((unsigned)U[((size_t)pm * 256 + r0 + r) * UP + yc + k] << 16); br[r][0] += yv * w0; br[r][1] += yv * w1; } }
#pragma unroll
                  for (int r = 0; r < 4; ++r) { mg[r][0] += sigmoid_f(ga[r][0] + p.b_merge[j * 1024 + c0]) * br[r][0]; mg[r][1] += sigmoid_f(ga[r][1] + p.b_merge[j * 1024 + c0 + 1]) * br[r][1]; }
              }
              __syncthreads();
#pragma unroll
              for (int r = 0; r < 4; ++r) { mrg[r * 1024 + c0] = mg[r][0]; mrg[r * 1024 + c0 + 1] = mg[r][1]; }
              __syncthreads();
              float ov[4][2];
              for (int r = 0; r < 4; ++r) { ov[r][0] = 0.f; ov[r][1] = 0.f; }
              for (int k = 0; k < 1024; ++k) { const float w0 = p.w_out[(size_t)k * 1024 + c0], w1 = p.w_out[(size_t)k * 1024 + c0 + 1];
#pragma unroll
                  for (int r = 0; r < 4; ++r) { const float mv = mrg[r * 1024 + k]; ov[r][0] += mv * w0; ov[r][1] += mv * w1; } }
#pragma unroll
              for (int r = 0; r < 4; ++r) { float ss = wave_sum(ov[r][0] * ov[r][0] + ov[r][1] * ov[r][1]); if ((t4 & 63) == 0) red[r * 8 + (t4 >> 6)] = ss; }
              __syncthreads();
#pragma unroll
              for (int r = 0; r < 4; ++r) { float ss = 0.f; for (int w = 0; w < 8; ++w) ss += red[r * 8 + w]; const float rstd = rsqrtf(ss * (1.0f / DM) + EPS); const size_t row = (size_t)pm * 256 + r0 + r;
                  p.out[row * DM + c0] = p.x[row * DM + c0] + ov[r][0] * rstd * p.g_post[c0]; p.out[row * DM + c0 + 1] = p.x[row * DM + c0 + 1] + ov[r][1] * rstd * p.g_post[c0 + 1]; }
              __syncthreads();
          }
          continue; }
#endif
#ifdef P3_NAIVE_S2
        {
          int t4 = threadIdx.x; asm volatile("" : "+v"(t4)); const int c0 = 2 * t4;
          for (int r0 = 0; r0 < 256; r0 += 4) {
              float mg[4][2];
              for (int r = 0; r < 4; ++r) { mg[r][0] = 0.f; mg[r][1] = 0.f; }
              for (int j = 0; j < 3; ++j) {
                  float ga[4][2], br[4][2];
                  for (int r = 0; r < 4; ++r) { ga[r][0] = ga[r][1] = br[r][0] = br[r][1] = 0.f; }
                  for (int k = 0; k < 1024; ++k) { const float w0 = p.w_in[(size_t)k * IN_COLS + 8200 + j * 1024 + c0], w1 = p.w_in[(size_t)k * IN_COLS + 8200 + j * 1024 + c0 + 1];
#pragma unroll
                      for (int r = 0; r < 4; ++r) { const float hv = __uint_as_float((unsigned)H[((size_t)pm * 256 + r0 + r) * 1024 + k] << 16); ga[r][0] += hv * w0; ga[r][1] += hv * w1; } }
                  const float* wj = j == 0 ? p.w_a : (j == 1 ? p.w_b : p.w_m); const int yc = j == 0 ? C_QA : (j == 1 ? C_QB : C_QM);
                  for (int k = 0; k < 512; ++k) { const float w0 = wj[(size_t)k * 1024 + c0], w1 = wj[(size_t)k * 1024 + c0 + 1];
#pragma unroll
                      for (int r = 0; r < 4; ++r) { const float yv = __uint_as_float((unsigned)U[((size_t)pm * 256 + r0 + r) * UP + yc + k] << 16); br[r][0] += yv * w0; br[r][1] += yv * w1; } }
#pragma unroll
                  for (int r = 0; r < 4; ++r) { mg[r][0] += sigmoid_f(ga[r][0] + p.b_merge[j * 1024 + c0]) * br[r][0]; mg[r][1] += sigmoid_f(ga[r][1] + p.b_merge[j * 1024 + c0 + 1]) * br[r][1]; }
              }
#pragma unroll
              for (int r = 0; r < 4; ++r) *(unsigned*)(Mg + (size_t)(r0 + r) * UP + c0) = pk_bf16(mg[r][0], mg[r][1]);
          }
          blk_sync_mem(); }
        for (int j = 3; j < 3; ++j) {
#else
        for (int j = 0; j < 3; ++j) {
#endif
#ifdef S2B_NAIVE
            { int t4 = threadIdx.x; asm volatile("" : "+v"(t4)); const int c0 = 2 * t4; const float* wj = j == 0 ? p.w_a : (j == 1 ? p.w_b : p.w_m); const int yc = j == 0 ? C_QA : (j == 1 ? C_QB : C_QM);
              for (int r0 = 0; r0 < 256; r0 += 8) { float br[8][2];
                  for (int r = 0; r < 8; ++r) { br[r][0] = 0.f; br[r][1] = 0.f; }
                  for (int k = 0; k < 512; ++k) { const float w0 = wj[(size_t)k * 1024 + c0], w1 = wj[(size_t)k * 1024 + c0 + 1];
#pragma unroll
                      for (int r = 0; r < 8; ++r) { const float yv = __uint_as_float((unsigned)U[((size_t)pm * 256 + r0 + r) * UP + yc + k] << 16); br[r][0] += yv * w0; br[r][1] += yv * w1; } }
#pragma unroll
                  for (int r = 0; r < 8; ++r) { const unsigned gw = *(const unsigned*)(Gt + (size_t)(r0 + r) * UP + c0); float z0 = br[r][0] * bf_lo(gw), z1 = br[r][1] * bf_hi(gw);
                      if (j > 0) { const unsigned mw = *(const unsigned*)(Mg + (size_t)(r0 + r) * UP + c0); z0 += bf_lo(mw); z1 += bf_hi(mw); }
                      *(unsigned*)(Mg + (size_t)(r0 + r) * UP + c0) = pk_bf16(z0, z1); } } }
#else
#ifndef NO_S2B
            { const bf16_t* Aj = U + (j == 0 ? C_QA : (j == 1 ? C_QB : C_QM)); const bf16_t* Wj = (const bf16_t*)(ws + OFF_WA + (size_t)j * MiB);
              pg8::Gemm g{Aj, Wj, NTOK, 1024, 512, UP}; PanelOrder S{pm, 0, 4}; EpiBr E{Mg, Gall + j * 1024, j == 0 ? 1 : 0, j, TP, UP};
              pg8::gemm_phase<EpiBr, PanelOrder, true, true>(lds, g, S, E); }
#endif
#endif
            blk_sync_mem();
        }
#if defined(DBG_STAGE) && DBG_STAGE == 2
        { int t4 = threadIdx.x; asm volatile("" : "+v"(t4)); const int lane = t4 & 63, wid = t4 >> 6;
          for (int rl = wid; rl < 256; rl += 8) { const size_t row = (size_t)pm * 256 + rl;
              for (int i = 0; i < 4; ++i) { const int k = 4 * lane + 256 * i; const u32x2 w = *(const u32x2*)(Mg + (size_t)rl * UP + k); const f32x4 xv = *(const f32x4*)(p.x + row * DM + k);
                  f32x4 o; o[0] = xv[0] + bf_lo(w.x); o[1] = xv[1] + bf_hi(w.x); o[2] = xv[2] + bf_lo(w.y); o[3] = xv[3] + bf_hi(w.y); *(f32x4*)(p.out + row * DM + k) = o; } }
          continue; }
#endif
#if defined(DBG_STAGE) && DBG_STAGE == 21
        continue;
#endif
#ifndef NO_S3
        { pg8::Gemm g{Mg, (const bf16_t*)(ws + OFF_WOUT), 256, 1024, DM, TP}; PanelOrder S{0, 0, 4}; EpiOut E{U + (size_t)pm * 256 * UP, (LAS3 float*)(lds + 131072), pm * 256};
          pg8::gemm_phase<EpiOut, PanelOrder, true, true>(lds, g, S, E); }
#endif
        blk_sync_mem();
#if defined(DBG_STAGE) && DBG_STAGE == 3
        { int t4 = threadIdx.x; asm volatile("" : "+v"(t4)); const int lane = t4 & 63, wid = t4 >> 6;
          for (int rl = wid; rl < 256; rl += 8) { const size_t row = (size_t)pm * 256 + rl;
              for (int i = 0; i < 4; ++i) { const int k = 4 * lane + 256 * i; const u32x2 w = *(const u32x2*)(U + row * UP + C_OUT + k); const f32x4 xv = *(const f32x4*)(p.x + row * DM + k);
                  f32x4 o; o[0] = xv[0] + bf_lo(w.x); o[1] = xv[1] + bf_hi(w.x); o[2] = xv[2] + bf_lo(w.y); o[3] = xv[3] + bf_hi(w.y); *(f32x4*)(p.out + row * DM + k) = o; } }
          continue; }
#endif
        int t4 = threadIdx.x; asm volatile("" : "+v"(t4));
        const int lane = t4 & 63, wid = t4 >> 6;
        for (int rl = wid; rl < 256; rl += 8) { const size_t row = (size_t)pm * 256 + rl;
            const LAS3 f32x4* sp = (const LAS3 f32x4*)(lds + 131072 + rl * 64); const f32x4 s0 = sp[0], s1 = sp[1], s2 = sp[2], s3 = sp[3];
            const float ssq = (((s0[0] + s0[1]) + (s0[2] + s0[3])) + ((s1[0] + s1[1]) + (s1[2] + s1[3]))) + (((s2[0] + s2[1]) + (s2[2] + s2[3])) + ((s3[0] + s3[1]) + (s3[2] + s3[3])));
            const float rstd = rsqrtf(ssq * (1.0f / DM) + EPS);
#pragma unroll
            for (int i = 0; i < 4; ++i) { const int k = 4 * lane + 256 * i; const u32x2 w = *(const u32x2*)(U + row * UP + C_OUT + k);
                const f32x4 xv = *(const f32x4*)(p.x + row * DM + k), gv = *(const f32x4*)(p.g_post + k);
                f32x4 o; o[0] = xv[0] + bf_lo(w.x) * rstd * gv[0]; o[1] = xv[1] + bf_hi(w.x) * rstd * gv[1]; o[2] = xv[2] + bf_lo(w.y) * rstd * gv[2]; o[3] = xv[3] + bf_hi(w.y) * rstd * gv[3];
                *(f32x4*)(p.out + row * DM + k) = o; } }
#ifdef DBG_GCHK
        { int t6 = threadIdx.x; asm volatile("" : "+v"(t6)); const float cdv = ((const float*)(ws + OFF_ROWSS))[(pm & 127) * 512 + t6]; if (cdv > 1.f) p.out[(size_t)pm * 256 * DM + t6] = cdv; }
#endif
#ifdef DBG_WCHK
        {
          int t4 = threadIdx.x; asm volatile("" : "+v"(t4)); int bad = 0;
          for (int e = pm * 512 + t4; e < 3072 * 1024; e += 256 * 512) { const int n = e >> 10, k = e & 1023;
              const float ref = p.w_in[(size_t)k * IN_COLS + 8200 + n]; const unsigned short want = (unsigned short)(pk_bf16(ref, 0.f) & 0xffffu);
              if (WT[(size_t)(8192 + n) * 1024 + k] != want) bad |= 1; }
          for (int e = pm * 512 + t4; e < 3 * 1024 * 1024; e += 256 * 512) { const int w = e >> 20, n = (e >> 10) & 1023, k = e & 1023;
              const float* src = w == 0 ? p.w_a : (w == 1 ? p.w_b : p.w_m); const float ref = k < 512 ? src[(size_t)k * 1024 + n] : 0.f; const unsigned short want = (unsigned short)(pk_bf16(ref, 0.f) & 0xffffu);
              if (((const bf16_t*)(ws + OFF_WP))[(size_t)w * 1024 * 1024 + (size_t)n * 1024 + k] != want) bad |= 2; }
          if (bad) p.out[(size_t)pm * 256 * DM + t4] = 1e4f * bad; }
#endif
        blk_sync_mem();
    }
}

__global__ void __launch_bounds__(512) mega(Params p, int ph_lo, int ph_hi) {
    extern __shared__ __attribute__((aligned(16))) unsigned char smem[];
    LAS3 unsigned char* lds = (LAS3 unsigned char*)smem;
    cg::grid_group grid = cg::this_grid();
#define MK_IN(k) (ph_lo <= (k) && (k) < ph_hi)
#define GSYNC() do { asm volatile("s_waitcnt vmcnt(0) lgkmcnt(0)" ::: "memory"); grid.sync(); if (threadIdx.x < 64) asm volatile("buffer_inv sc1\n\ts_waitcnt vmcnt(0)" ::: "memory"); __syncthreads(); } while (0)
#ifndef NO_P0
    if (MK_IN(0)) { phase0(p, lds); if (MK_IN(1)) GSYNC(); }
#endif
#ifndef NO_P1
    if (MK_IN(1)) { phase1(p, lds); if (MK_IN(2)) GSYNC(); }
#endif
#ifndef NO_P2
    if (MK_IN(2)) { phase2(p, lds); if (MK_IN(3)) GSYNC(); }
#endif
#ifndef NO_P3
    if (MK_IN(3)) phase3(p, lds);
#endif
}
}

#ifndef MK_N_LAUNCHES
#define MK_N_LAUNCHES 1
#endif
extern "C" void kernel_launch(void* const* d_in, const int* in_sizes, int n_in, void* d_out, int out_size, void* d_ws, size_t ws_size, hipStream_t stream) {
    static int grid = 0;
    if (grid == 0) {
        if (n_in != 14 || in_sizes[0] != mk::NTOK * mk::DM || out_size != mk::NTOK * mk::DM || ws_size < mk::WS_NEED) { fprintf(stderr, "kernel_launch: unexpected shapes / workspace (%zu)\n", ws_size); grid = -1; return; }
        int dev = 0, cus = 0, per_cu = 0;
        hipGetDevice(&dev); hipDeviceGetAttribute(&cus, hipDeviceAttributeMultiprocessorCount, dev);
        hipFuncSetAttribute((const void*)mk::mega, hipFuncAttributeMaxDynamicSharedMemorySize, mk::LDS_BYTES);
        hipOccupancyMaxActiveBlocksPerMultiprocessor(&per_cu, (const void*)mk::mega, 512, mk::LDS_BYTES);
        if (per_cu < 1) per_cu = 1;
        grid = cus * per_cu;
    }
    if (grid < 0) return;
    mk::Params p{};
    p.x = (const float*)d_in[0]; p.mem = (const float*)d_in[1]; p.pos = (const int*)d_in[2]; p.g_pre = (const float*)d_in[3]; p.g_post = (const float*)d_in[4]; p.g_mem = (const float*)d_in[5];
    p.w_in = (const float*)d_in[6]; p.b_forget = (const float*)d_in[7]; p.b_merge = (const float*)d_in[8]; p.w_mem_kv = (const float*)d_in[9]; p.w_a = (const float*)d_in[10]; p.w_b = (const float*)d_in[11];
    p.w_m = (const float*)d_in[12]; p.w_out = (const float*)d_in[13]; p.out = (float*)d_out; p.ws = (unsigned char*)d_ws;
#if MK_N_LAUNCHES == 1
    int lo = 0, hi = 4; void* args[] = {&p, &lo, &hi};
    hipError_t e = hipLaunchCooperativeKernel((const void*)mk::mega, dim3(grid), dim3(512), args, mk::LDS_BYTES, stream);
    if (e != hipSuccess) fprintf(stderr, "cooperative launch failed: %s (grid %d)\n", hipGetErrorString(e), grid);
#else
    for (int ph = 0; ph < 4; ++ph) hipLaunchKernelGGL(mk::mega, dim3(grid), dim3(512), mk::LDS_BYTES, stream, p, ph, ph + 1);
#endif
}
```
